# Optimizing an MI355X kernel written in HIP

```python
import math
import jax, jax.numpy as jnp
from jax import lax
import numpy as np

D_MODEL = 2048
BATCH = 2
SEQ = 4096
DEPTH = 4

A_HEADS = 4
A_QK_DIM = 64
A_V_DIM = 2 * A_QK_DIM
Q_BLOCK = 128
ROPE_THETA = 10000.0
B_HEADS = 6
B_DK = 128
B_DV = 128
B_CHUNK = 16
C_HEADS = 6
C_DK = 128
C_DV = 128
CONV_K = 4
C_CHUNK = 64
D_MIX = A_HEADS * A_V_DIM + B_HEADS * B_DV + C_HEADS * C_DV
IN_SPLITS = (
    A_HEADS * 2 * A_QK_DIM, A_HEADS * 2 * A_QK_DIM, A_HEADS * A_V_DIM,
    B_HEADS * B_DK, B_HEADS * B_DK, B_HEADS * B_DV, B_HEADS * B_DV,
    C_HEADS * C_DK, C_HEADS * C_DK, C_HEADS * C_DV, C_HEADS * C_DV,
    C_HEADS, C_HEADS,
)
D_IN = sum(IN_SPLITS)
D_FF = 5632
EPS = 1e-6

kernel_name = "hymba_style_diffattn_hgrn2_gdn_macaron"

F32 = jnp.float32


def rmsnorm(x, w):
    xf = x.astype(F32)
    y = xf * lax.rsqrt(jnp.mean(xf * xf, axis=-1, keepdims=True) + EPS)
    return (y * w.astype(F32)).astype(x.dtype)


def l2norm(x):
    return x * lax.rsqrt(jnp.sum(x * x, axis=-1, keepdims=True) + EPS)


def swiglu(h, w_gate, w_up, w_down):
    return (jax.nn.silu(h @ w_gate) * (h @ w_up)) @ w_down


def split_heads(t, n_heads):
    b, s, c = t.shape
    return t.reshape(b, s, n_heads, c // n_heads).transpose(0, 2, 1, 3)


def merge_heads(t):
    b, h, s, d = t.shape
    return t.transpose(0, 2, 1, 3).reshape(b, s, h * d)


def rope(t, pos):
    half = t.shape[-1] // 2
    inv_freq = 1.0 / (ROPE_THETA ** (jnp.arange(half, dtype=F32) / half))
    ang = pos.astype(F32)[:, None] * inv_freq[None, :]
    cos, sin = jnp.cos(ang), jnp.sin(ang)
    t1, t2 = t[..., :half], t[..., half:]
    return jnp.concatenate([t1 * cos - t2 * sin, t2 * cos + t1 * sin], axis=-1)


def causal_depthwise_conv(x, w):
    c = x.shape[-1]
    return lax.conv_general_dilated(
        x, w[:, None, :], window_strides=(1,), padding=[(CONV_K - 1, 0)],
        dimension_numbers=("NWC", "WIO", "NWC"), feature_group_count=c)


def diff_attention(q_in, k_in, v_in, lq1, lk1, lq2, lk2, gain, lambda_init):
    bn, s, _ = q_in.shape
    q = q_in.astype(F32).reshape(bn, s, A_HEADS, 2, A_QK_DIM).transpose(0, 2, 3, 1, 4)
    k = k_in.astype(F32).reshape(bn, s, A_HEADS, 2, A_QK_DIM).transpose(0, 2, 3, 1, 4)
    v = split_heads(v_in.astype(F32), A_HEADS)
    pos = jnp.arange(s)
    q = rope(q, pos) * (A_QK_DIM ** -0.5)
    k = rope(k, pos)
    lam = (jnp.exp(jnp.sum(lq1.astype(F32) * lk1.astype(F32)))
           - jnp.exp(jnp.sum(lq2.astype(F32) * lk2.astype(F32))) + lambda_init)
    outs = []
    for blk in range(s // Q_BLOCK):
        q0 = blk * Q_BLOCK
        kend = q0 + Q_BLOCK
        scores = jnp.einsum("bhcqd,bhckd->bhcqk", q[:, :, :, q0:kend], k[:, :, :, :kend])
        mask = (q0 + jnp.arange(Q_BLOCK))[:, None] >= jnp.arange(kend)[None, :]
        p = jax.nn.softmax(jnp.where(mask, scores, -jnp.inf), axis=-1)
        w = p[:, :, 0] - lam * p[:, :, 1]
        outs.append(jnp.einsum("bhqk,bhkd->bhqd", w, v[:, :, :kend]))
    o = jnp.concatenate(outs, axis=2)
    o = rmsnorm(o, gain) * (1.0 - lambda_init)
    return merge_heads(o)


def hgrn2(q_in, f_in, i_in, g_in, lower_bound, gain):
    bn, s, _ = q_in.shape
    q = jax.nn.silu(split_heads(q_in.astype(F32), B_HEADS))
    lb = lower_bound.astype(F32).reshape(B_HEADS, 1, B_DK)
    f = lb + (1.0 - lb) * jax.nn.sigmoid(split_heads(f_in.astype(F32), B_HEADS))
    log_f = jnp.log(f)
    k = 1.0 - f
    v = split_heads(i_in.astype(F32), B_HEADS)
    n = s // B_CHUNK

    def to_chunks(t):
        return jnp.moveaxis(t.reshape(bn, B_HEADS, n, B_CHUNK, t.shape[-1]), 2, 0)

    qc, kc, vc = to_chunks(q), to_chunks(k), to_chunks(v)
    bc = jnp.cumsum(to_chunks(log_f), axis=-2)
    causal = jnp.tril(jnp.ones((B_CHUNK, B_CHUNK), dtype=bool))[:, :, None]

    def step(state, inp):
        qn, kn, vn, bnk = inp
        b_last = bnk[:, :, -1:, :]
        diff = bnk[:, :, :, None, :] - bnk[:, :, None, :, :]
        decay = jnp.exp(jnp.where(causal, diff, -jnp.inf))
        attn = jnp.einsum("bhtd,bhsd,bhtsd->bhts", qn, kn, decay)
        o = (jnp.einsum("bhts,bhse->bhte", attn, vn)
             + jnp.einsum("bhtd,bhde->bhte", qn * jnp.exp(bnk), state))
        new_state = (jnp.exp(b_last)[:, :, 0, :, None] * state
                     + jnp.einsum("bhsd,bhse->bhde", kn * jnp.exp(b_last - bnk), vn))
        return new_state, o

    state0 = jnp.zeros((bn, B_HEADS, B_DK, B_DV), F32)
    _, o = lax.scan(step, state0, (qc, kc, vc, bc))
    o = jnp.moveaxis(o, 0, 2).reshape(bn, B_HEADS, s, B_DV)
    o = rmsnorm(o, gain) * jax.nn.silu(split_heads(g_in.astype(F32), B_HEADS))
    return merge_heads(o)


def gated_deltanet(q_in, k_in, v_in, z_in, beta_in, a_in, conv_w, a_log, dt_bias, gain):
    bn, s, _ = q_in.shape
    qkv = jnp.concatenate([q_in, k_in, v_in], axis=-1).astype(F32)
    qkv = jax.nn.silu(causal_depthwise_conv(qkv, conv_w.astype(F32)))
    q, k, v = jnp.split(qkv, [C_HEADS * C_DK, 2 * C_HEADS * C_DK], axis=-1)
    q = l2norm(split_heads(q, C_HEADS)) * (C_DK ** -0.5)
    k = l2norm(split_heads(k, C_HEADS))
    v = split_heads(v, C_HEADS)
    beta = jax.nn.sigmoid(beta_in.astype(F32)).transpose(0, 2, 1)
    g = (-jnp.exp(a_log.astype(F32))[None, :, None]
         * jax.nn.softplus(a_in.astype(F32).transpose(0, 2, 1) + dt_bias.astype(F32)[None, :, None]))
    n = s // C_CHUNK
    qc = q.reshape(bn, C_HEADS, n, C_CHUNK, C_DK)
    kc = k.reshape(bn, C_HEADS, n, C_CHUNK, C_DK)
    vc = v.reshape(bn, C_HEADS, n, C_CHUNK, C_DV)
    betac = beta.reshape(bn, C_HEADS, n, C_CHUNK)
    bc = jnp.cumsum(g.reshape(bn, C_HEADS, n, C_CHUNK), axis=-1)

    incl = jnp.tril(jnp.ones((C_CHUNK, C_CHUNK), dtype=bool))
    strict = jnp.tril(jnp.ones((C_CHUNK, C_CHUNK), dtype=bool), -1)
    decay = jnp.exp(jnp.where(incl, bc[..., :, None] - bc[..., None, :], -jnp.inf))
    k_beta = kc * betac[..., None]
    v_beta = vc * betac[..., None]
    l_mat = jnp.where(strict, jnp.einsum("bhnid,bhnjd->bhnij", k_beta, kc) * decay, 0.0)
    eye = jnp.eye(C_CHUNK, dtype=F32)
    rhs = jnp.concatenate([v_beta, k_beta * jnp.exp(bc)[..., None]], axis=-1)
    sol = lax.linalg.triangular_solve(eye + l_mat, rhs, left_side=True, lower=True,
                                      unit_diagonal=True)
    u, w = sol[..., :C_DV], sol[..., C_DV:]
    attn = jnp.einsum("bhnid,bhnjd->bhnij", qc, kc) * decay

    def mv(t):
        return jnp.moveaxis(t, 2, 0)

    def step(state, inp):
        qn, kn, un, wn, bnk, an = inp
        v_new = un - jnp.einsum("bhld,bhde->bhle", wn, state)
        o = (jnp.einsum("bhld,bhde->bhle", qn * jnp.exp(bnk)[..., None], state)
             + jnp.einsum("bhij,bhje->bhie", an, v_new))
        b_last = bnk[..., -1]
        new_state = (state * jnp.exp(b_last)[..., None, None]
                     + jnp.einsum("bhld,bhle->bhde", kn * jnp.exp(b_last[..., None] - bnk)[..., None], v_new))
        return new_state, o

    state0 = jnp.zeros((bn, C_HEADS, C_DK, C_DV), F32)
    _, o = lax.scan(step, state0, (mv(qc), mv(kc), mv(u), mv(w), mv(bc), mv(attn)))
    o = jnp.moveaxis(o, 0, 2).reshape(bn, C_HEADS, s, C_DV)
    o = rmsnorm(o, gain) * jax.nn.silu(split_heads(z_in.astype(F32), C_HEADS))
    return merge_heads(o)


def setup_inputs(seed: int = 0) -> dict:
    key = jax.random.key(seed)
    ks = iter(jax.random.split(key, 32))

    def nrm(shape, scale):
        return jax.random.normal(next(ks), shape, F32) * scale

    def gain(shape):
        return 1.0 + nrm(shape, 0.02)

    return {
        "x": nrm((BATCH, SEQ, D_MODEL), 1.0),
        "ffn1_norm": gain((DEPTH, D_MODEL)),
        "ffn1_w_gate": nrm((DEPTH, D_MODEL, D_FF), D_MODEL ** -0.5),
        "ffn1_w_up": nrm((DEPTH, D_MODEL, D_FF), D_MODEL ** -0.5),
        "ffn1_w_down": nrm((DEPTH, D_FF, D_MODEL), D_FF ** -0.5),
        "mix_norm": gain((DEPTH, D_MODEL)),
        "w_in": nrm((DEPTH, D_MODEL, D_IN), D_MODEL ** -0.5),
        "w_out": nrm((DEPTH, D_MIX, D_MODEL), D_MIX ** -0.5),
        "lambda_q1": nrm((DEPTH, A_QK_DIM), 0.1),
        "lambda_k1": nrm((DEPTH, A_QK_DIM), 0.1),
        "lambda_q2": nrm((DEPTH, A_QK_DIM), 0.1),
        "lambda_k2": nrm((DEPTH, A_QK_DIM), 0.1),
        "diff_gain": gain((DEPTH, A_V_DIM)),
        "hgrn_lb_param": nrm((DEPTH, B_HEADS * B_DK), 0.1),
        "hgrn_gain": gain((DEPTH, B_DV)),
        "gdn_conv_w": nrm((DEPTH, CONV_K, C_HEADS * (2 * C_DK + C_DV)), CONV_K ** -0.5),
        "gdn_a_log": jnp.log(jax.random.uniform(next(ks), (DEPTH, C_HEADS), F32, 1.0, 16.0)),
        "gdn_dt_bias": nrm((DEPTH, C_HEADS), 0.1),
        "gdn_gain": gain((DEPTH, C_DV)),
        "ffn2_norm": gain((DEPTH, D_MODEL)),
        "ffn2_w_gate": nrm((DEPTH, D_MODEL, D_FF), D_MODEL ** -0.5),
        "ffn2_w_up": nrm((DEPTH, D_MODEL, D_FF), D_MODEL ** -0.5),
        "ffn2_w_down": nrm((DEPTH, D_FF, D_MODEL), D_FF ** -0.5),
        "final_norm": gain((D_MODEL,)),
    }


def reference(x, ffn1_norm, ffn1_w_gate, ffn1_w_up, ffn1_w_down, mix_norm, w_in, w_out,
              lambda_q1, lambda_k1, lambda_q2, lambda_k2, diff_gain,
              hgrn_lb_param, hgrn_gain, gdn_conv_w, gdn_a_log, gdn_dt_bias, gdn_gain,
              ffn2_norm, ffn2_w_gate, ffn2_w_up, ffn2_w_down, final_norm):
    lbs = jax.nn.softmax(hgrn_lb_param.astype(F32), axis=0)
    lbs = jnp.cumsum(lbs, axis=0) - lbs[0]
    split_points = []
    acc = 0
    for sz in IN_SPLITS[:-1]:
        acc += sz
        split_points.append(acc)

    for l in range(DEPTH):
        h = rmsnorm(x, ffn1_norm[l])
        x = x + 0.5 * swiglu(h, ffn1_w_gate[l], ffn1_w_up[l], ffn1_w_down[l])
        h = rmsnorm(x, mix_norm[l])
        (aq, ak, av, bq, bf, bi, bg, cq, ck, cv, cz, cb, ca) = jnp.split(h @ w_in[l], split_points, axis=-1)
        lambda_init = 0.8 - 0.6 * math.exp(-0.3 * l)
        oa = diff_attention(aq, ak, av, lambda_q1[l], lambda_k1[l], lambda_q2[l], lambda_k2[l],
                            diff_gain[l], lambda_init)
        ob = hgrn2(bq, bf, bi, bg, lbs[l], hgrn_gain[l])
        oc = gated_deltanet(cq, ck, cv, cz, cb, ca, gdn_conv_w[l], gdn_a_log[l], gdn_dt_bias[l],
                            gdn_gain[l])
        mixed = jnp.concatenate([oa, ob, oc], axis=-1).astype(x.dtype)
        x = x + mixed @ w_out[l]
        h = rmsnorm(x, ffn2_norm[l])
        x = x + 0.5 * swiglu(h, ffn2_w_gate[l], ffn2_w_up[l], ffn2_w_down[l])
    return rmsnorm(x, final_norm)
```

```cpp
#include <hip/hip_runtime.h>
#include <cstdio>
#include <cstdint>

#ifndef MK_PER_PHASE
#define MK_PER_PHASE 0
#endif

#define PROBE_DUP 0
#define PROBE_VAR 0
#define DI __device__ __forceinline__
#define GAS __attribute__((address_space(1)))
#define LAS __attribute__((address_space(3)))
typedef unsigned short bf16;
typedef unsigned v4u __attribute__((ext_vector_type(4)));
typedef unsigned v2u __attribute__((ext_vector_type(2)));
typedef float f32x4 __attribute__((ext_vector_type(4)));
typedef float f32x2 __attribute__((ext_vector_type(2)));
typedef float f32x16 __attribute__((ext_vector_type(16)));
typedef short bf16x8 __attribute__((ext_vector_type(8)));
typedef short s16x4 __attribute__((ext_vector_type(4)));
typedef __bf16 bf16x2_t __attribute__((ext_vector_type(2)));
typedef GAS unsigned gu32;
#define CAS __attribute__((address_space(4)))
typedef const float* cfptr;
#define RLX_AGENT __ATOMIC_RELAXED, __HIP_MEMORY_SCOPE_AGENT
#define LDS_WAIT() asm volatile("s_waitcnt lgkmcnt(0)" ::: "memory")
#define VM_WAIT() asm volatile("s_waitcnt vmcnt(0)" ::: "memory")

constexpr int BATCH = 2, SEQ = 4096, M = BATCH * SEQ, D = 2048, DEPTH = 4, DFF = 5632, DIN = 7692, DINP = 7936, NP = 7680, NGU = 2 * DFF;
constexpr int NFFN = 2 * DEPTH;
constexpr float EPS = 1e-6f;
constexpr int PA_Q = 0, PA_K = 512, PA_V = 1024, PB_Q = 1536, PB_F = 2304, PB_I = 3072, PB_G = 3840, PC_Q = 4608, PC_K = 5376, PC_V = 6144, PC_Z = 6912;
constexpr int MIX_A = 0, MIX_B = 512, MIX_C = 1280;

DI unsigned pk2(float lo, float hi) { f32x2 v = {lo, hi}; bf16x2_t b = __builtin_convertvector(v, bf16x2_t); return __builtin_bit_cast(unsigned, b); }
DI float bf2f(unsigned v) { return __uint_as_float(v << 16); }
DI float bflo(unsigned w) { return __uint_as_float(w << 16); }
DI float bfhi(unsigned w) { return __uint_as_float(w & 0xffff0000u); }
DI float fexp2(float x) { return __builtin_amdgcn_exp2f(x); }
DI float fexp(float x) { return __builtin_amdgcn_exp2f(x * 1.4426950408889634f); }
DI float flog(float x) { return __builtin_amdgcn_logf(x) * 0.6931471805599453f; }
DI float frcp(float x) { return __builtin_amdgcn_rcpf(x); }
DI float frsq(float x) { return __builtin_amdgcn_rsqf(x); }
DI float sigm(float x) { return frcp(1.f + fexp(-x)); }
DI float silu(float x) { return x * sigm(x); }
DI float softplus(float x) { return fmaxf(x, 0.f) + flog(1.f + fexp(-fabsf(x))); }
DI float wave_sum(float v) {
#pragma unroll
    for (int o = 1; o < 64; o <<= 1) v += __shfl_xor(v, o);
    return v;
}
DI constexpr int permk(int g, int j) { return (j < 4) ? (4 * g + j) : (16 + 4 * g + (j - 4)); }
constexpr size_t MiB = 1u << 20;
constexpr size_t WS_CTL = 0, CTL_ZERO_BYTES = 1 * MiB;
constexpr size_t SZ_WGU1 = (size_t)NGU * D * 2, SZ_WD1 = (size_t)D * DFF * 2, SZ_WIN1 = (size_t)DINP * D * 2, SZ_WOUT1 = (size_t)D * D * 2;
constexpr size_t WS_WGU = 1 * MiB;
constexpr size_t WS_WD = WS_WGU + NFFN * SZ_WGU1;
constexpr size_t WS_WIN = WS_WD + NFFN * SZ_WD1;
constexpr size_t WS_WOUT = WS_WIN + DEPTH * SZ_WIN1;
constexpr size_t WS_XB = WS_WOUT + DEPTH * SZ_WOUT1;
constexpr size_t WS_ACT = WS_XB + (size_t)M * D * 2;
constexpr size_t WS_P = WS_ACT + (size_t)M * DFF * 2;
constexpr size_t WS_PBA = WS_P + (size_t)M * NP * 2;
constexpr size_t WS_MIX = WS_PBA + (size_t)M * 16 * 4;
constexpr size_t WS_ROPE = WS_MIX + (size_t)M * D * 2;
constexpr size_t WS_LBS = WS_ROPE + (size_t)SEQ * 32 * 8;
constexpr size_t WS_QR = WS_LBS + 64 * 1024;
constexpr size_t WS_KF = WS_QR + (size_t)M * 512 * 2;
constexpr size_t WS_VF = WS_KF + (size_t)M * 512 * 2;
constexpr size_t WS_HQ = WS_VF + (size_t)M * 512 * 2;
constexpr size_t WS_HK = WS_HQ + (size_t)12 * 128 * 8192;
constexpr size_t WS_HV = WS_HK + (size_t)12 * 128 * 8192;
constexpr size_t WS_HA = WS_HV + (size_t)12 * 128 * 8192;
constexpr size_t WS_HE = WS_HA + (size_t)12 * 128 * 2048;
constexpr size_t WS_GW = WS_HE + (size_t)12 * 128 * 512;
constexpr size_t WS_GQ = WS_GW + (size_t)12 * 64 * 16384;
constexpr size_t WS_GK = WS_GQ + (size_t)12 * 64 * 16384;
constexpr size_t WS_GA = WS_GK + (size_t)12 * 64 * 16384;
constexpr size_t WS_GU = WS_GA + (size_t)12 * 64 * 8192;
constexpr size_t WS_GE = WS_GU + (size_t)12 * 64 * 32768;
constexpr size_t WS_XLO = WS_GE + 64 * 1024;
constexpr size_t WS_GZ = WS_XLO + (size_t)M * D;
constexpr size_t WS_END = WS_GZ + (size_t)12 * SEQ * 128 * 2;
constexpr int CW_TMO = 0, CW_CODE = 1;
constexpr int CW_QUEUE = 64;
constexpr int CW_BAR = 4096;
constexpr int CW_ROWSQ = 16384;
static_assert(CW_ROWSQ * 4 + 13 * M * 8 <= (int)CTL_ZERO_BYTES, "CTL region");
constexpr int LDS_BYTES = 163840;
constexpr int MISC_OFF = LDS_BYTES - 256;
namespace pg8 {
#define PG8_LAS __attribute__((address_space(3)))
typedef unsigned short bf16_t;
typedef short bf16x8 __attribute__((ext_vector_type(8)));
typedef float f32x4 __attribute__((ext_vector_type(4)));
typedef unsigned u32x4 __attribute__((ext_vector_type(4)));
constexpr int BM = 256, BK = 64, HALF = 128, HTB = HALF * BK * 2  , STAGE_BYTES = 8 * HTB, NXCD = 8, WGM = 8;

__host__ __device__ __forceinline__ int lds_byte(int r, int c) { const int st = (r >> 4) * 2 + (c >> 5), rr = r & 15, cc = c & 31, ob = rr * 64 + cc * 2; return st * 1024 + (ob ^ (((ob >> 9) & 1) << 5)); }
__host__ __device__ __forceinline__ void stage_rc(int b, int& R, int& C) { const int st = b / 1024, sb = b % 1024, swz = sb ^ (((sb >> 9) & 1) << 5); R = (st >> 1) * 16 + swz / 64; C = (st & 1) * 32 + (swz % 64) / 2; }
__host__ __device__ __forceinline__ int perm32(int rho) { const int n = rho >> 4, i = rho & 15; return 8 * (i >> 2) + 4 * n + (i & 3); }

struct Unit { int pm, pn; };
struct Gemm { const bf16_t* A; const bf16_t* Bt; int M, N, K; };

struct StaticOrder {
    int nM, nN, nwg, G, c;
    __host__ __device__ void init(int M, int N, int G_, int c_) { nM = M / BM; nN = N / BM; nwg = nM * nN; G = G_; c = c_; }
    __host__ __device__ bool next(int i, Unit& u) const {
        const long L = (long)i * G + c; if (L >= nwg) return false;
        int wgid = (int)L; { const int q = nwg / NXCD, r = nwg % NXCD, xcd = wgid % NXCD, off = wgid / NXCD; wgid = (xcd < r ? xcd * (q + 1) : r * (q + 1) + (xcd - r) * q) + off; }
        const int nig = WGM * nN, gid = wgid / nig, fm = gid * WGM, gsz = (nM - fm) < WGM ? (nM - fm) : WGM;
        u.pm = fm + ((wgid % nig) % gsz); u.pn = (wgid % nig) / gsz; return true;
    }
    __device__ __forceinline__ void a_ready(const Unit&) const {}
    __device__ __forceinline__ void done(const Unit&) const {}
};

__device__ __forceinline__ unsigned cvt_pk_bf16(float lo, float hi) { unsigned r; asm volatile("v_cvt_pk_bf16_f32 %0, %1, %2" : "=v"(r) : "v"(lo), "v"(hi)); return r; }
#define PG8_GAS __attribute__((address_space(1)))
__device__ __forceinline__ float e_exp(float x) { return __builtin_amdgcn_exp2f(x * 1.4426950408889634f); }
__device__ __forceinline__ float e_silu(float x) { return x * __builtin_amdgcn_rcpf(1.f + e_exp(-x)); }
__device__ __forceinline__ unsigned e_pk2(float lo, float hi) { typedef float f2 __attribute__((ext_vector_type(2))); typedef __bf16 b2 __attribute__((ext_vector_type(2))); f2 v = {lo, hi}; b2 b = __builtin_convertvector(v, b2); return __builtin_bit_cast(unsigned, b); }

struct EpiGateUp {
    static constexpr bool PERM = true, AFTER_DRAIN = false;
    bf16_t* ACT; const unsigned long long* rowsq;
    int ldc;
    __device__ __forceinline__ void operator()(const f32x4 (&acc)[2][2][4][2], const Unit& u, int wr, int wc, int fr, int fq) const {
        const int row0 = u.pm * BM + wr * 64 + fr, col0 = u.pn * HALF + wc * 32 + 8 * fq;
        unsigned long long rq[2][4];
#pragma unroll
        for (int ai = 0; ai < 2; ++ai)
#pragma unroll
            for (int m = 0; m < 4; ++m) rq[ai][m] = ((const PG8_GAS unsigned long long*)rowsq)[row0 + ai * HALF + m * 16];
#pragma unroll
        for (int ai = 0; ai < 2; ++ai)
#pragma unroll
            for (int m = 0; m < 4; ++m) {
                const int row = row0 + ai * HALF + m * 16;
                const float rs = __builtin_amdgcn_rsqf((float)rq[ai][m] * (1.0f / (2048.0f * 16777216.0f)) + 1e-6f);
                float o[8];
#pragma unroll
                for (int n = 0; n < 2; ++n)
#pragma unroll
                    for (int j = 0; j < 4; ++j) { const float g = acc[ai][0][m][n][j] * rs, up = acc[ai][1][m][n][j] * rs; o[4 * n + j] = e_silu(g) * up; }
                u32x4 w; w.x = e_pk2(o[0], o[1]); w.y = e_pk2(o[2], o[3]); w.z = e_pk2(o[4], o[5]); w.w = e_pk2(o[6], o[7]);
                *(PG8_GAS u32x4*)(ACT + (size_t)row * ldc + col0) = w;
            }
    }
};
__device__ __forceinline__ float e_x24(unsigned h16, unsigned l8) { return __uint_as_float(((h16 - (l8 >> 7)) << 16) | (l8 << 8)); }
struct EpiResid {
    static constexpr bool PERM = true, AFTER_DRAIN = false;
    const bf16_t* hin; const unsigned char* lin; bf16_t* hout; unsigned char* lout; unsigned long long* rowsq_out; float scale;
    __device__ __forceinline__ void operator()(const f32x4 (&acc)[2][2][4][2], const Unit& u, int wr, int wc, int fr, int fq) const {
        const int row0 = u.pm * BM + wr * 64 + fr, col0 = u.pn * BM + wc * 32 + 8 * fq, lcol = u.pn * BM + (wc * 4 + fq) * 16;
#pragma unroll
        for (int ai = 0; ai < 2; ++ai) {
            u32x4 L4[4], H4[4][2];
#pragma unroll
            for (int m = 0; m < 4; ++m) {
                const int row = row0 + ai * HALF + m * 16; const size_t off = (size_t)row * 2048 + col0, loff = (size_t)row * 2048 + lcol;
                L4[m] = *(const PG8_GAS u32x4*)(lin + loff); H4[m][0] = *(const PG8_GAS u32x4*)(hin + off); H4[m][1] = *(const PG8_GAS u32x4*)(hin + off + HALF);
            }
#pragma unroll
            for (int m = 0; m < 4; ++m) {
                const int row = row0 + ai * HALF + m * 16; const size_t off = (size_t)row * 2048 + col0, loff = (size_t)row * 2048 + lcol; float ss = 0.f;
                const u32x4 l4 = L4[m];
                u32x4 lo4;
#pragma unroll
                for (int bj = 0; bj < 2; ++bj) {
                    const u32x4 h4 = H4[m][bj];
                    u32x4 ho;
#pragma unroll
                    for (int j = 0; j < 4; ++j) {
                        const unsigned lw = l4[2 * bj + (j >> 1)], lb0 = (lw >> (16 * (j & 1))) & 0xffu, lb1 = (lw >> (16 * (j & 1) + 8)) & 0xffu;
                        const float x0 = e_x24(h4[j] & 0xffffu, lb0) + acc[ai][bj][m][j >> 1][2 * (j & 1)] * scale, x1 = e_x24(h4[j] >> 16, lb1) + acc[ai][bj][m][j >> 1][2 * (j & 1) + 1] * scale;
                        const unsigned b0 = __float_as_uint(x0), b1 = __float_as_uint(x1);
                        ho[j] = ((b0 + 0x8000u) >> 16) | ((b1 + 0x8000u) & 0xffff0000u);
                        const unsigned nb = ((b0 >> 8) & 0xffu) | (b1 & 0xff00u);
                        if ((j & 1) == 0) lo4[2 * bj + (j >> 1)] = nb; else lo4[2 * bj + (j >> 1)] |= nb << 16;
                        ss += x0 * x0 + x1 * x1;
                    }
                    *(PG8_GAS u32x4*)(hout + off + bj * HALF) = ho;
                }
                *(PG8_GAS u32x4*)(lout + loff) = lo4;
                ss += __shfl_xor(ss, 16); ss += __shfl_xor(ss, 32);
                if (fq == 0) __hip_atomic_fetch_add((PG8_GAS unsigned long long*)(rowsq_out + row), (unsigned long long)(ss * 16777216.0f + 0.5f), __ATOMIC_RELAXED, __HIP_MEMORY_SCOPE_AGENT);
            }
        }
    }
};
struct EpiWin {
    static constexpr bool PERM = true, AFTER_DRAIN = false;
    bf16_t* P; float* PBA; const unsigned long long* rowsq; int ldp;
    __device__ __forceinline__ void operator()(const f32x4 (&acc)[2][2][4][2], const Unit& u, int wr, int wc, int fr, int fq) const {
        const int row0 = u.pm * BM + wr * 64 + fr, col0 = u.pn * BM + wc * 32 + 8 * fq;
        const bool tail = (u.pn == 30);
        unsigned long long rq[2][4];
#pragma unroll
        for (int ai = 0; ai < 2; ++ai)
#pragma unroll
            for (int m = 0; m < 4; ++m) rq[ai][m] = ((const PG8_GAS unsigned long long*)rowsq)[row0 + ai * HALF + m * 16];
#pragma unroll
        for (int ai = 0; ai < 2; ++ai)
#pragma unroll
            for (int m = 0; m < 4; ++m) {
                const int row = row0 + ai * HALF + m * 16;
                const float rs = __builtin_amdgcn_rsqf((float)rq[ai][m] * (1.0f / (2048.0f * 16777216.0f)) + 1e-6f);
                if (!tail) {
#pragma unroll
                    for (int bj = 0; bj < 2; ++bj) {
                        const f32x4 v0 = acc[ai][bj][m][0] * rs, v1 = acc[ai][bj][m][1] * rs;
                        u32x4 w; w.x = e_pk2(v0[0], v0[1]); w.y = e_pk2(v0[2], v0[3]); w.z = e_pk2(v1[0], v1[1]); w.w = e_pk2(v1[2], v1[3]);
                        *(PG8_GAS u32x4*)(P + (size_t)row * ldp + col0 + bj * HALF) = w;
                    }
                } else if (wc == 0 && fq < 2) {
                    *(PG8_GAS f32x4*)(PBA + (size_t)row * 16 + 8 * fq) = acc[ai][0][m][0] * rs;
                    *(PG8_GAS f32x4*)(PBA + (size_t)row * 16 + 8 * fq + 4) = acc[ai][0][m][1] * rs;
                }
            }
    }
};
template <class Epi, class Sched, bool ALIGN_EPI = false, bool SP2 = false>
__device__ __forceinline__ void gemm_phase(PG8_LAS unsigned char* lds, const Gemm g, const Sched& S, const Epi& E, const int tid) {
    const int wid = __builtin_amdgcn_readfirstlane(tid >> 6), lane = tid & 63, wr = wid >> 2, wc = wid & 3, fr = lane & 15, fq = lane >> 4;
    const int K = g.K, nt = K / BK;
    unsigned voffA[2], voffB[2];
#pragma unroll
    for (int i = 0; i < 2; ++i) { int R, C; stage_rc(tid * 16 + i * 8192, R, C); const int Rb = Epi::PERM ? ((R & ~31) + perm32(R & 31)) : R;
        voffA[i] = (unsigned)(R * K + C) * 2u; voffB[i] = (unsigned)(Rb * K + C) * 2u; }
    const size_t kstep = (size_t)(BK * 2);
    const size_t hstep = (size_t)HALF * K * 2;
    const size_t tstep = 2 * hstep;
    const unsigned ldsw = (unsigned)wid * 1024u;
    const int aoff = lds_byte(wr * 64 + fr, fq * 8), boff = lds_byte(wc * 32 + fr, fq * 8);
#define PG8_SA(b, h) (((b) * 2 + (h)) * HTB)
#define PG8_SB(b, h) ((4 + (b) * 2 + (h)) * HTB)
#define PG8_STAGE(bufoff, gbase, voff) do { _Pragma("unroll") for (int _i = 0; _i < 2; ++_i) \
        __builtin_amdgcn_global_load_lds((const unsigned*)((const char*)(gbase) + (voff)[_i]), (PG8_LAS unsigned*)(lds + (bufoff) + ldsw + _i * 8192), 16, 0, 0); } while (0)
#define PG8_LDA(dst, b, h) do { _Pragma("unroll") for (int m = 0; m < 4; ++m) _Pragma("unroll") for (int k = 0; k < 2; ++k) dst[m][k] = *(const PG8_LAS bf16x8*)(lds + PG8_SA(b, h) + aoff + m * 2048 + k * 1024); } while (0)
#define PG8_LDB(dst, b, h) do { _Pragma("unroll") for (int n = 0; n < 2; ++n) _Pragma("unroll") for (int k = 0; k < 2; ++k) dst[n][k] = *(const PG8_LAS bf16x8*)(lds + PG8_SB(b, h) + boff + n * 2048 + k * 1024); } while (0)
#define PG8_MMA(ai, bj, At, Bt) do { __builtin_amdgcn_s_setprio(1); _Pragma("unroll") for (int m = 0; m < 4; ++m) _Pragma("unroll") for (int n = 0; n < 2; ++n) _Pragma("unroll") for (int k = 0; k < 2; ++k) \
        acc[ai][bj][m][n] = __builtin_amdgcn_mfma_f32_16x16x32_bf16(Bt[n][k], At[m][k], acc[ai][bj][m][n], 0, 0, 0); __builtin_amdgcn_s_setprio(0); } while (0)
#define PG8_WAIT_V(n) asm volatile("s_waitcnt vmcnt(" #n ")" ::: "memory")
#define PG8_WAIT_L(n) asm volatile("s_waitcnt lgkmcnt(" #n ")" ::: "memory")
#define PG8_BAR __builtin_amdgcn_s_barrier()
#define PG8_SCHED __builtin_amdgcn_sched_barrier(0)
    Unit cur, nxt; int ui = 0;
    if (!S.next(0, cur)) return;
    f32x4 acc[2][2][4][2];
#pragma unroll
    for (int a = 0; a < 2; ++a)
#pragma unroll
        for (int b = 0; b < 2; ++b)
#pragma unroll
            for (int m = 0; m < 4; ++m)
#pragma unroll
                for (int n = 0; n < 2; ++n) acc[a][b][m][n] = (f32x4){0.f, 0.f, 0.f, 0.f};
    bf16x8 At[4][2], B0[2][2], B1[2][2];
    const char* cA = (const char*)g.A + (size_t)cur.pm * tstep; const char* cB = (const char*)g.Bt + (size_t)cur.pn * tstep;
    S.a_ready(cur);
    if constexpr (SP2) {
        PG8_STAGE(PG8_SB(0, 0), cB, voffB); PG8_STAGE(PG8_SB(0, 1), cB + hstep, voffB); PG8_STAGE(PG8_SA(0, 0), cA, voffA); PG8_STAGE(PG8_SA(0, 1), cA + hstep, voffA);
        if (wr == 1) PG8_BAR;
        PG8_WAIT_V(2); PG8_BAR;
        PG8_STAGE(PG8_SB(1, 0), cB + kstep, voffB); PG8_STAGE(PG8_SA(1, 0), cA + kstep, voffA); PG8_STAGE(PG8_SB(1, 1), cB + hstep + kstep, voffB);
        PG8_WAIT_V(6); PG8_BAR;
    } else {
        PG8_STAGE(PG8_SB(0, 0), cB, voffB); PG8_STAGE(PG8_SA(0, 0), cA, voffA); PG8_STAGE(PG8_SB(0, 1), cB + hstep, voffB); PG8_STAGE(PG8_SA(0, 1), cA + hstep, voffA);
        if (wr == 1) PG8_BAR;
        PG8_WAIT_V(4); PG8_BAR;
        PG8_STAGE(PG8_SB(1, 0), cB + kstep, voffB); PG8_STAGE(PG8_SA(1, 0), cA + kstep, voffA); PG8_STAGE(PG8_SB(1, 1), cB + hstep + kstep, voffB);
        PG8_WAIT_V(6); PG8_BAR;
    }
    for (;;) {
        const bool has_next = S.next(ui + 1, nxt);
        const char* nA = has_next ? (const char*)g.A + (size_t)nxt.pm * tstep : cA; const char* nB = has_next ? (const char*)g.Bt + (size_t)nxt.pn * tstep : cB;
        for (int t = 0; t < nt; t += 2) {
            const bool last = (t == nt - 2);
            const char* a1 = cA + (size_t)(t + 1) * kstep;
            const char* a2 = last ? nA : cA + (size_t)(t + 2) * kstep; const char* b2 = last ? nB : cB + (size_t)(t + 2) * kstep;
            const char* a3 = a2 + kstep; const char* b3 = b2 + kstep;
            if (last && has_next) S.a_ready(nxt);
            if constexpr (SP2) {
            PG8_LDB(B0, 0, 0); PG8_LDB(B1, 0, 1); PG8_SCHED; PG8_LDA(At, 0, 0); PG8_STAGE(PG8_SA(1, 1), a1 + hstep, voffA);
            PG8_WAIT_V(8); PG8_WAIT_L(0); PG8_BAR; PG8_MMA(0, 0, At, B0); PG8_MMA(0, 1, At, B1); PG8_BAR; PG8_SCHED;
            PG8_LDA(At, 0, 1); PG8_STAGE(PG8_SB(0, 0), b2, voffB); PG8_STAGE(PG8_SB(0, 1), b2 + hstep, voffB); PG8_STAGE(PG8_SA(0, 0), a2, voffA);
            PG8_WAIT_V(8); PG8_WAIT_L(0); PG8_BAR; PG8_MMA(1, 0, At, B0); PG8_MMA(1, 1, At, B1); PG8_BAR; PG8_SCHED;
            PG8_LDB(B0, 1, 0); PG8_LDB(B1, 1, 1); PG8_SCHED; PG8_LDA(At, 1, 0); PG8_STAGE(PG8_SA(0, 1), a2 + hstep, voffA);
            PG8_WAIT_V(8); PG8_WAIT_L(0); PG8_BAR; PG8_MMA(0, 0, At, B0); PG8_MMA(0, 1, At, B1); PG8_BAR; PG8_SCHED;
            PG8_LDA(At, 1, 1); PG8_STAGE(PG8_SB(1, 0), b3, voffB); PG8_STAGE(PG8_SB(1, 1), b3 + hstep, voffB); PG8_STAGE(PG8_SA(1, 0), a3, voffA);
            PG8_WAIT_V(8); PG8_WAIT_L(0); PG8_BAR; PG8_MMA(1, 0, At, B0); PG8_MMA(1, 1, At, B1); PG8_BAR; PG8_SCHED;
            } else {
            PG8_LDB(B0, 0, 0); PG8_SCHED; PG8_LDA(At, 0, 0); PG8_STAGE(PG8_SA(1, 1), a1 + hstep, voffA);
            PG8_WAIT_L(8); PG8_BAR; PG8_WAIT_L(0); PG8_MMA(0, 0, At, B0); PG8_BAR; PG8_SCHED;
            PG8_LDB(B1, 0, 1); PG8_STAGE(PG8_SB(0, 0), b2, voffB);
            PG8_BAR; PG8_WAIT_L(0); PG8_MMA(0, 1, At, B1); PG8_BAR;
            PG8_LDA(At, 0, 1); PG8_STAGE(PG8_SA(0, 0), a2, voffA);
            PG8_BAR; PG8_WAIT_L(0); PG8_MMA(1, 0, At, B0); PG8_BAR; PG8_SCHED;
            PG8_STAGE(PG8_SB(0, 1), b2 + hstep, voffB);
            PG8_WAIT_V(6); PG8_BAR; PG8_MMA(1, 1, At, B1); PG8_BAR;
            PG8_LDB(B0, 1, 0); PG8_SCHED; PG8_LDA(At, 1, 0); PG8_STAGE(PG8_SA(0, 1), a2 + hstep, voffA);
            PG8_WAIT_L(8); PG8_BAR; PG8_WAIT_L(0); PG8_MMA(0, 0, At, B0); PG8_BAR; PG8_SCHED;
            PG8_LDB(B1, 1, 1); PG8_STAGE(PG8_SB(1, 0), b3, voffB);
            PG8_BAR; PG8_WAIT_L(0); PG8_MMA(0, 1, At, B1); PG8_BAR;
            PG8_LDA(At, 1, 1); PG8_STAGE(PG8_SA(1, 0), a3, voffA);
            PG8_BAR; PG8_WAIT_L(0); PG8_MMA(1, 0, At, B0); PG8_BAR; PG8_SCHED;
            PG8_STAGE(PG8_SB(1, 1), b3 + hstep, voffB);
            PG8_WAIT_V(6); PG8_BAR; PG8_MMA(1, 1, At, B1); PG8_BAR;
            }
        }
        if constexpr (ALIGN_EPI) { if (wr == 0) PG8_BAR; }
        if constexpr (!Epi::AFTER_DRAIN) { E(acc, cur, wr, wc, fr, fq); S.done(cur); }
        if (!has_next) break;
#pragma unroll
        for (int a = 0; a < 2; ++a)
#pragma unroll
            for (int b = 0; b < 2; ++b)
#pragma unroll
                for (int m = 0; m < 4; ++m)
#pragma unroll
                    for (int n = 0; n < 2; ++n) acc[a][b][m][n] = (f32x4){0.f, 0.f, 0.f, 0.f};
        cur = nxt; cA = nA; cB = nB; ++ui;
        if constexpr (ALIGN_EPI) { if (wr == 1) PG8_BAR; }
    }
    PG8_WAIT_V(0);
    if constexpr (!ALIGN_EPI) { if (wr == 0) PG8_BAR; }
    PG8_BAR;
    if constexpr (Epi::AFTER_DRAIN) { E.fused(acc, cur, wr, wc, fr, fq, lds, wid, lane); S.done(cur); }
#undef PG8_SA
#undef PG8_SB
#undef PG8_STAGE
#undef PG8_LDA
#undef PG8_LDB
#undef PG8_MMA
#undef PG8_WAIT_V
#undef PG8_WAIT_L
#undef PG8_BAR
#undef PG8_SCHED
}
}
#define XB_TMO      128
#define XB_XCNT(j)  (256  + 64 * (j))
#define XB_XSUB(j)  (1280 + 64 * (j))
#define XB_XGEN(j)  (2304 + 64 * (j))
#define XB_TOP      3328
#define XB_TOPGEN   3392
#define XCD_BAR_WORDS 3456
#define XB_SPIN_CAP (1u << 18)

__device__ __forceinline__ unsigned xb_ld(unsigned* p)              { return __hip_atomic_load(p, __ATOMIC_RELAXED, __HIP_MEMORY_SCOPE_AGENT); }
__device__ __forceinline__ unsigned xb_add(unsigned* p, unsigned v) { return __hip_atomic_fetch_add(p, v, __ATOMIC_RELAXED, __HIP_MEMORY_SCOPE_AGENT); }
__device__ __forceinline__ unsigned xb_xcc_id() { return (unsigned)__builtin_amdgcn_s_getreg((3 << 11) | 20) & 0xFu; }
#define XB_SPIN(cond, bar) do { unsigned _sp = 0; while (cond) { __builtin_amdgcn_s_sleep(1); \
    if ((++_sp & 255u) == 0u) { if (xb_ld(&(bar)[XB_TMO])) break; if (_sp > XB_SPIN_CAP) { atomicAdd(&(bar)[XB_TMO], 1u); break; } } } } while (0)

struct XcdBarrier {
    unsigned* bar; unsigned x;
    volatile LAS unsigned* st;
};

__device__ __forceinline__ XcdBarrier xcd_barrier_post(unsigned* bar, volatile LAS unsigned* st) {
    XcdBarrier b; b.bar = bar; b.x = xb_xcc_id(); b.st = st;
    if (threadIdx.x == 0) (void)xb_add(&bar[XB_XCNT(b.x)], 1u);
    return b;
}
__device__ __forceinline__ void xcd_barrier_complete(unsigned* bar, unsigned x, unsigned& nloc, unsigned& nx) {
    const unsigned G = gridDim.x * gridDim.y * gridDim.z;
    unsigned sum, cnt, mine, sp = 0u;
    for (;;) {
        sum = 0u; cnt = 0u; mine = 0u;
        unsigned cv[16];
#pragma unroll
        for (unsigned j = 0; j < 16; ++j) cv[j] = xb_ld(&bar[XB_XCNT(j)]);
#pragma unroll
        for (unsigned j = 0; j < 16; ++j) { const unsigned c = cv[j]; sum += c; cnt += (c > 0u) ? 1u : 0u; mine = (j == x) ? c : mine; }
        if (sum == G) break;
        __builtin_amdgcn_s_sleep(1);
        if ((++sp & 255u) == 0u) { if (xb_ld(&bar[XB_TMO])) break; if (sp > XB_SPIN_CAP) { atomicAdd(&bar[XB_TMO], 1u); break; } }
    }
    nloc = mine > 0u ? mine : 1u; nx = cnt > 0u ? cnt : 1u;
}

__device__ __forceinline__ void xcd_barrier(const XcdBarrier& b) {
    asm volatile("s_waitcnt vmcnt(0)" ::: "memory");
    __syncthreads();
    if (threadIdx.x == 0) {
        unsigned* bar = b.bar;
        __builtin_amdgcn_s_waitcnt(0);
        unsigned nloc = b.st[0], nx = b.st[1];
        if (nloc == 0u) { xcd_barrier_complete(bar, b.x, nloc, nx); b.st[0] = nloc; b.st[1] = nx; }
        const unsigned old = xb_add(&bar[XB_XSUB(b.x)], 1u);
        const unsigned gen = old / nloc;
        if (old + 1u == (gen + 1u) * nloc) {
            __builtin_amdgcn_fence(__ATOMIC_RELEASE, "agent");
            asm volatile("s_waitcnt vmcnt(0)" ::: "memory");
            const unsigned og = xb_add(&bar[XB_TOP], 1u);
            const unsigned tg = og / nx;
            if (og + 1u == (tg + 1u) * nx) xb_add(&bar[XB_TOPGEN], 1u);
            else XB_SPIN(xb_ld(&bar[XB_TOPGEN]) == tg, bar);
            __builtin_amdgcn_fence(__ATOMIC_ACQUIRE, "agent");
            xb_add(&bar[XB_XGEN(b.x)], 1u);
            asm volatile("s_waitcnt vmcnt(0)" ::: "memory");
        } else {
            XB_SPIN(xb_ld(&bar[XB_XGEN(b.x)]) == gen, bar);
            __builtin_amdgcn_fence(__ATOMIC_ACQUIRE, "agent");
            asm volatile("s_waitcnt vmcnt(0)" ::: "memory");
        }
    }
    __syncthreads();
}
struct Frame {
    LAS unsigned char* lds;
    volatile LAS unsigned* MISC;
    gu32* ctl;
    unsigned char* ws;
    int tid, lane, wave;
    int vcu, G;
    const CAS cfptr* in;
    float* out;
};
DI unsigned long long* rowsq_ptr(const Frame& F, int v) { return (unsigned long long*)(F.ws + WS_CTL + (size_t)CW_ROWSQ * 4) + (size_t)v * M; }

struct TrItem { const float* W; const float* sc; bf16* dst; int N, Kd, k0, n0, drow0; };
constexpr int I_G = (D / 64) * (DFF / 64);
constexpr int I_IN = (D / 64) * 121;
constexpr int I_OUT = (D / 64) * (D / 64);
constexpr int I_LAYER = 6 * I_G + I_IN + I_OUT;
constexpr int I_TOTAL = DEPTH * I_LAYER;
constexpr int CV_P0 = 2 * I_G;
constexpr int CV_G = 128 * 8 * 9, CV_W = 32 * 8 * 7, CV_M = 232 * 8 * 2, CV_LAYER = 2 * CV_G + CV_W + CV_M;
DI void cv_slot(int l, int j, int& lo, int& hi) {
    const int off = (j == 0) ? 0 : (j == 1) ? CV_G : (j == 2) ? CV_G + CV_W : CV_G + CV_W + CV_M, cap = (j == 0 || j == 3) ? CV_G : (j == 1) ? CV_W : CV_M;
    const int s0 = CV_P0 + l * CV_LAYER + off; lo = s0 < I_TOTAL ? s0 : I_TOTAL; hi = (s0 + cap) < I_TOTAL ? (s0 + cap) : I_TOTAL;
}
DI void tr_decode(const Frame& F, int git, TrItem& t) {
    const int l = git / I_LAYER; int r = git - l * I_LAYER;
    int s = 0;
    if (r >= 3 * I_G + I_IN + I_OUT) { s = 1; r -= 3 * I_G + I_IN + I_OUT; }
    if (r < 3 * I_G) {
        const int kind = r / I_G; r -= kind * I_G; const int f = 2 * l + s;
        if (kind < 2) {
            const int up = kind;
            t.W = F.in[s ? (up ? 21 : 20) : (up ? 3 : 2)] + (size_t)l * D * DFF; t.sc = F.in[s ? 19 : 1] + l * D;
            const int kb = r / (DFF / 64), nb = r % (DFF / 64); t.k0 = 64 * kb; t.n0 = 64 * nb; t.N = DFF; t.Kd = D;
            t.dst = (bf16*)(F.ws + WS_WGU + (size_t)f * SZ_WGU1); t.drow0 = 256 * (t.n0 >> 7) + (t.n0 & 127) + (up ? 128 : 0);
        } else {
            t.W = F.in[s ? 22 : 4] + (size_t)l * DFF * D; t.sc = nullptr;
            const int kb = r / (D / 64), nb = r % (D / 64); t.k0 = 64 * kb; t.n0 = 64 * nb; t.N = D; t.Kd = DFF;
            t.dst = (bf16*)(F.ws + WS_WD + (size_t)f * SZ_WD1); t.drow0 = t.n0;
        }
        return;
    }
    r -= 3 * I_G;
    if (r < I_IN) {
        t.W = F.in[6] + (size_t)l * D * DIN; t.sc = F.in[5] + l * D;
        const int kb = r / 121, nb = r % 121; t.k0 = 64 * kb; t.n0 = 64 * nb; t.N = DIN; t.Kd = D;
        t.dst = (bf16*)(F.ws + WS_WIN + (size_t)l * SZ_WIN1); t.drow0 = t.n0;
        return;
    }
    r -= I_IN;
    {
        t.W = F.in[7] + (size_t)l * D * D; t.sc = nullptr;
        const int kb = r / (D / 64), nb = r % (D / 64); t.k0 = 64 * kb; t.n0 = 64 * nb; t.N = D; t.Kd = D;
        t.dst = (bf16*)(F.ws + WS_WOUT + (size_t)l * SZ_WOUT1); t.drow0 = t.n0;
    }
}
DI void tr_load(const TrItem& t, int lane, f32x4 (&v)[16], f32x4 (&sc)[2], int variant = 0) {
    sc[0] = (f32x4){1.f, 1.f, 1.f, 1.f}; sc[1] = sc[0];
    if (t.sc) { sc[0] = *(const GAS f32x4*)(t.sc + t.k0 + 8 * (lane & 7)); sc[1] = *(const GAS f32x4*)(t.sc + t.k0 + 8 * (lane & 7) + 4); }
    if (variant & 2) {
#pragma unroll
        for (int i = 0; i < 16; ++i) v[i] = (f32x4){1.f, 2.f, 3.f, 4.f};
        return; }
    const int n = t.n0 + 4 * (lane & 15); const bool ok = n < t.N;
    const float* p = t.W + (size_t)(t.k0 + (lane >> 4)) * t.N + n;
#pragma unroll
    for (int i = 0; i < 16; ++i) v[i] = ok ? __builtin_nontemporal_load((const GAS f32x4*)(p + (size_t)(4 * i) * t.N)) : (f32x4){0.f, 0.f, 0.f, 0.f};
}
DI void tr_store(const TrItem& t, int lane, const f32x4 (&v)[16], const f32x4 (&sc)[2], LAS float* scr, int variant = 0) {
    if (variant & 1) {
        const int c = lane & 7;
#pragma unroll
        for (int j = 0; j < 8; ++j) { const int nn = (lane >> 3) + 8 * j; v4u o; o.x = pk2(v[2 * j].x, v[2 * j].y); o.y = pk2(v[2 * j].z, v[2 * j].w); o.z = pk2(v[2 * j + 1].x, v[2 * j + 1].y); o.w = pk2(v[2 * j + 1].z, v[2 * j + 1].w);
            *(GAS v4u*)(t.dst + (size_t)(t.drow0 + nn) * t.Kd + t.k0 + 8 * c) = o; }
        return;
    }
    {
        LAS float* w = scr + (lane >> 4) * 65 + 4 * (lane & 15);
#pragma unroll
        for (int i = 0; i < 16; ++i) { w[(4 * i) * 65 + 0] = v[i].x; w[(4 * i) * 65 + 1] = v[i].y; w[(4 * i) * 65 + 2] = v[i].z; w[(4 * i) * 65 + 3] = v[i].w; }
    }
    LDS_WAIT(); asm volatile("" ::: "memory");
    const int c = lane & 7;
    const f32x4 s0 = sc[0], s1 = sc[1];
#pragma unroll
    for (int j = 0; j < 8; ++j) {
        const int nn = (lane >> 3) + 8 * j; const LAS float* s = scr + (8 * c) * 65 + nn;
        v4u o; o.x = pk2(s[0 * 65] * s0.x, s[1 * 65] * s0.y); o.y = pk2(s[2 * 65] * s0.z, s[3 * 65] * s0.w); o.z = pk2(s[4 * 65] * s1.x, s[5 * 65] * s1.y); o.w = pk2(s[6 * 65] * s1.z, s[7 * 65] * s1.w);
        if (!(variant & 4)) *(GAS v4u*)(t.dst + (size_t)(t.drow0 + nn) * t.Kd + t.k0 + 8 * c) = o;
        else asm volatile("" :: "v"(o));
    }
    LDS_WAIT(); asm volatile("" ::: "memory");
}
DI void sincos_d(double x, double& s, double& c) {
    const double x2 = x * x;
    double ps = 0.0, pc = 0.0;
    double ts = 1.0, tc = 1.0;
    double ss = 0.0, cc = 0.0;
#pragma unroll
    for (int k = 0; k < 15; ++k) {
        ss += ts; cc += tc;
        ts = -ts * x2 / (double)((2 * k + 2) * (2 * k + 3));
        tc = -tc * x2 / (double)((2 * k + 1) * (2 * k + 2));
    }
    (void)ps; (void)pc;
    s = ss * x; c = cc;
}
DI void convert_range(const Frame& F, int lo, int hi, int wi, int wn, LAS float* scr, int variant = 0) {
    TrItem cur, nxt; f32x4 va[16], vb[16], sa[2], sb[2];
    int it = lo + wi;
    if (it < hi) { tr_decode(F, it, cur); tr_load(cur, F.lane, va, sa, variant); }
#pragma unroll 1
    for (; it < hi; it += 2 * wn) {
        const bool h1 = it + wn < hi;
        if (h1) { tr_decode(F, it + wn, nxt); tr_load(nxt, F.lane, vb, sb, variant); }
        __builtin_amdgcn_sched_barrier(0);
        tr_store(cur, F.lane, va, sa, scr, variant);
        if (!h1) break;
        const bool h2 = it + 2 * wn < hi;
        if (h2) { tr_decode(F, it + 2 * wn, cur); tr_load(cur, F.lane, va, sa, variant); }
        __builtin_amdgcn_sched_barrier(0);
        tr_store(nxt, F.lane, vb, sb, scr, variant);
        if (!h2) break;
    }
}
DI void p0_prologue(Frame& F, int variant = 0) {
    LAS float* scr = (LAS float*)(F.lds + F.wave * 16896);
    const bool split = (F.G == 256);
    const bool conv_role = !split || ((blockIdx.x & 1) == 0), misc_role = !split || ((blockIdx.x & 1) == 1);
    const int rk = split ? (int)(blockIdx.x >> 1) : F.vcu, nrk = split ? 128 : F.G;
    const int gw = rk * 8 + F.wave, NGW = nrk * 8;
    if (conv_role) convert_range(F, 0, split ? CV_P0 : I_TOTAL, gw, NGW, scr, variant);
    if (!misc_role) return;
    {
        const size_t per = (size_t)(DINP - 7744) * D * 2 / 16;
        const size_t gt = (size_t)(rk * 512 + F.tid), NT = (size_t)nrk * 512;
        for (size_t i = gt; i < per * DEPTH; i += NT) { const size_t l = i / per, o = i % per;
            *(GAS v4u*)(F.ws + WS_WIN + l * SZ_WIN1 + (size_t)7744 * D * 2 + o * 16) = (v4u){0u, 0u, 0u, 0u}; }
    }
    {
        const float* x = F.in[0]; bf16* xb = (bf16*)(F.ws + WS_XB); unsigned char* xl = F.ws + WS_XLO; unsigned long long* rq = rowsq_ptr(F, 0);
        for (int m = gw; m < M; m += NGW) {
            const GAS f32x4* xr = (const GAS f32x4*)(x + (size_t)m * D) + F.lane; GAS v2u* o = (GAS v2u*)(xb + (size_t)m * D) + F.lane; float s = 0.f;
            f32x4 vv[8];
#pragma unroll
            for (int j = 0; j < 8; ++j) vv[j] = xr[64 * j];
#pragma unroll
            for (int j = 0; j < 8; ++j) {
                const f32x4 v = vv[j]; s += (v.x * v.x + v.y * v.y) + (v.z * v.z + v.w * v.w);
                const unsigned b0 = __float_as_uint(v.x), b1 = __float_as_uint(v.y), b2 = __float_as_uint(v.z), b3 = __float_as_uint(v.w);
                v2u w; w.x = ((b0 + 0x8000u) >> 16) | ((b1 + 0x8000u) & 0xffff0000u); w.y = ((b2 + 0x8000u) >> 16) | ((b3 + 0x8000u) & 0xffff0000u); o[64 * j] = w;
                const int c = 256 * j + 4 * F.lane, cl = c & 255, bj = cl >> 7, wc = (cl & 127) >> 5, fq = (cl & 31) >> 3, k = cl & 7;
                *(GAS unsigned*)(xl + (size_t)m * D + (c & ~255) + ((wc * 4 + fq) * 2 + bj) * 8 + k) = ((b0 >> 8) & 0xffu) | (b1 & 0xff00u) | ((b2 << 8) & 0xff0000u) | ((b3 << 16) & 0xff000000u);
            }
            s = wave_sum(s); if (F.lane == 0) rq[m] = (unsigned long long)(s * 16777216.0f + 0.5f);
        }
    }
    {
        f32x2* tab = (f32x2*)(F.ws + WS_ROPE);
        const int gt = rk * 512 + F.tid, NT = nrk * 512;
        for (int e = gt; e < SEQ * 32; e += NT) {
            const int t = e >> 5, i = e & 31;
            const double w = exp2(-(double)i * (13.287712379549449 / 32.0));
            double rev = (double)t * w * 0.15915494309189535; rev -= rint(rev);
            double s, c; sincos_d(rev * 6.283185307179586, s, c);
            tab[e] = (f32x2){(float)c, (float)s};
        }
    }
    {
        float* lbs = (float*)(F.ws + WS_LBS); const float* p = F.in[13];
        const int gt = rk * 512 + F.tid;
        if (gt < 768) {
            float v0 = p[gt], v1 = p[768 + gt], v2 = p[1536 + gt], v3 = p[2304 + gt];
            const float mx = fmaxf(fmaxf(v0, v1), fmaxf(v2, v3));
            v0 = fexp(v0 - mx); v1 = fexp(v1 - mx); v2 = fexp(v2 - mx); v3 = fexp(v3 - mx);
            const float inv = 1.f / (v0 + v1 + v2 + v3);
            lbs[gt] = 0.f; lbs[768 + gt] = v1 * inv; lbs[1536 + gt] = (v1 + v2) * inv; lbs[2304 + gt] = (v1 + v2 + v3) * inv;
        }
        if (gt >= 1024 && gt < 1024 + DEPTH) {
            const int l = gt - 1024; float a = 0.f, b = 0.f;
            for (int i = 0; i < 64; ++i) { a += F.in[8][l * 64 + i] * F.in[9][l * 64 + i]; b += F.in[10][l * 64 + i] * F.in[11][l * 64 + i]; }
            const float li = 0.8f - 0.6f * expf(-0.3f * (float)l);
            float* lam = (float*)(F.ws + WS_LBS + 16384);
            lam[2 * l] = expf(a) - expf(b) + li; lam[2 * l + 1] = li;
        }
    }
}
DI void attn_prep_job(const Frame& F, int job) {
    const int bh = job >> 6, tile = job & 63, b = bh >> 2, h = bh & 3;
    const bf16* P = (const bf16*)(F.ws + WS_P);
    const f32x2* rope = (const f32x2*)(F.ws + WS_ROPE);
    const int tid = F.tid;
    {
        const int kk = tid >> 3, c = (tid >> 2) & 1, dg = tid & 3, t = tile * 64 + kk; const size_t m = (size_t)b * SEQ + t;
        float cs[8], sn[8];
#pragma unroll
        for (int i = 0; i < 8; ++i) { const f32x2 v = rope[t * 32 + 8 * dg + i]; cs[i] = v.x; sn[i] = v.y; }
        v4u la[2], lb[2];
#pragma unroll
        for (int isk = 0; isk < 2; ++isk) { const bf16* src = P + m * NP + (isk ? PA_K : PA_Q) + h * 128 + c * 64 + 8 * dg; la[isk] = *(const GAS v4u*)src; lb[isk] = *(const GAS v4u*)(src + 32); }
#pragma unroll
        for (int isk = 0; isk < 2; ++isk) {
            const v4u a = la[isk], bb = lb[isk];
            float x1[8], x2[8];
            x1[0] = bflo(a.x); x1[1] = bfhi(a.x); x1[2] = bflo(a.y); x1[3] = bfhi(a.y); x1[4] = bflo(a.z); x1[5] = bfhi(a.z); x1[6] = bflo(a.w); x1[7] = bfhi(a.w);
            x2[0] = bflo(bb.x); x2[1] = bfhi(bb.x); x2[2] = bflo(bb.y); x2[3] = bfhi(bb.y); x2[4] = bflo(bb.z); x2[5] = bfhi(bb.z); x2[6] = bflo(bb.w); x2[7] = bfhi(bb.w);
            const float sc = isk ? 1.0f : 0.125f * 1.4426950408889634f;
            float o1[8], o2[8];
#pragma unroll
            for (int i = 0; i < 8; ++i) { o1[i] = (x1[i] * cs[i] - x2[i] * sn[i]) * sc; o2[i] = (x2[i] * cs[i] + x1[i] * sn[i]) * sc; }
            v4u w1, w2; w1.x = pk2(o1[0], o1[1]); w1.y = pk2(o1[2], o1[3]); w1.z = pk2(o1[4], o1[5]); w1.w = pk2(o1[6], o1[7]);
            w2.x = pk2(o2[0], o2[1]); w2.y = pk2(o2[2], o2[3]); w2.z = pk2(o2[4], o2[5]); w2.w = pk2(o2[6], o2[7]);
            if (!isk) {
                bf16* q = (bf16*)(F.ws + WS_QR) + (((size_t)bh * 2 + c) * SEQ + t) * 64 + 8 * dg;
                *(GAS v4u*)q = w1; *(GAS v4u*)(q + 32) = w2;
            } else {
                unsigned char* kf = F.ws + WS_KF + (((size_t)bh * 2 + c) * 64 + tile) * 8192;
                const int kvb = kk >> 5, r32 = kk & 31;
                const int d1 = 8 * dg, d2 = 32 + 8 * dg;
                *(GAS v4u*)(kf + ((kvb * 4 + (d1 >> 4)) * 64 + r32 + 32 * ((d1 >> 3) & 1)) * 16) = w1;
                *(GAS v4u*)(kf + ((kvb * 4 + (d2 >> 4)) * 64 + r32 + 32 * ((d2 >> 3) & 1)) * 16) = w2;
            }
        }
    }
    {
        unsigned char* vf = F.ws + WS_VF + ((size_t)bh * 64 + tile) * 16384;
        unsigned short ev[2][8];
#pragma unroll
        for (int rep = 0; rep < 2; ++rep) {
            const int task = tid + 512 * rep, dv = task & 127, grp = task >> 7, kb = grp >> 2, s = (grp >> 1) & 1, hh = grp & 1;
            const GAS bf16* src = (const GAS bf16*)(P + ((size_t)b * SEQ + tile * 64 + 32 * kb + 16 * s + 4 * hh) * NP + PA_V + h * 128 + dv);
#pragma unroll
            for (int j = 0; j < 8; ++j) ev[rep][j] = src[(size_t)(8 * (j >> 2) + (j & 3)) * NP];
        }
#pragma unroll
        for (int rep = 0; rep < 2; ++rep) {
            const int task = tid + 512 * rep, dv = task & 127, grp = task >> 7, kb = grp >> 2, s = (grp >> 1) & 1, hh = grp & 1;
            const unsigned short* e = ev[rep];
            v4u w; w.x = e[0] | ((unsigned)e[1] << 16); w.y = e[2] | ((unsigned)e[3] << 16); w.z = e[4] | ((unsigned)e[5] << 16); w.w = e[6] | ((unsigned)e[7] << 16);
            *(GAS v4u*)(vf + ((((dv >> 5) * 2 + kb) * 2 + s) * 64 + (dv & 31) + 32 * hh) * 16) = w;
        }
    }
}

DI void hgrn_prep_job(const Frame& F, int job, int layer, LAS unsigned char* scr) {
    const int bh = job >> 7, ch = job & 127, b = bh / 6, h = bh % 6, lane = F.lane;
    const bf16* P = (const bf16*)(F.ws + WS_P);
    const size_t m0 = (size_t)b * SEQ + ch * 32;
    const float* lbs = (const float*)(F.ws + WS_LBS) + layer * 768 + h * 128;
    LAS unsigned char* QL = scr; LAS unsigned char* KL = scr + 8704;
    unsigned char* hq = F.ws + WS_HQ + ((size_t)bh * 128 + ch) * 8192;
    unsigned char* hk = F.ws + WS_HK + ((size_t)bh * 128 + ch) * 8192;
    unsigned char* hv = F.ws + WS_HV + ((size_t)bh * 128 + ch) * 8192;
    unsigned char* ha = F.ws + WS_HA + ((size_t)bh * 128 + ch) * 2048;
    float* he = (float*)(F.ws + WS_HE + ((size_t)bh * 128 + ch) * 512);
#pragma unroll 1
    for (int half = 0; half < 2; ++half) {
        const int dk = 64 * half + lane;
        const float lb = ((const GAS float*)lbs)[dk];
        const GAS bf16* pq = (const GAS bf16*)(P + m0 * NP + PB_Q + h * 128 + dk); const GAS bf16* pf = (const GAS bf16*)(P + m0 * NP + PB_F + h * 128 + dk); const GAS bf16* pv = (const GAS bf16*)(P + m0 * NP + PB_I + h * 128 + dk);
        unsigned short ve[32];
#pragma unroll
        for (int t = 0; t < 32; ++t) ve[t] = pv[(size_t)t * NP];
        float bq[32], kv[32], qv[32]; float bsum = 0.f;
        unsigned short qe[32], fe[32];
#pragma unroll
        for (int t = 0; t < 32; ++t) { qe[t] = pq[(size_t)t * NP]; fe[t] = pf[(size_t)t * NP]; }
#pragma unroll
        for (int t = 0; t < 32; ++t) {
            const float qx = bf2f(qe[t]), fx = bf2f(fe[t]);
            const float f = lb + (1.f - lb) * sigm(fx);
            bsum += flog(f); bq[t] = bsum; kv[t] = 1.f - f; qv[t] = silu(qx);
        }
        ((GAS float*)he)[dk] = fexp(bsum);
#pragma unroll
        for (int t = 0; t < 32; ++t) {
            const float e = fexp(bq[t]);
            *(LAS bf16*)(QL + t * 272 + dk * 2) = (bf16)(pk2(qv[t] * e, 0.f) & 0xffffu);
            *(LAS bf16*)(KL + t * 272 + dk * 2) = (bf16)(pk2(kv[t] * frcp(e), 0.f) & 0xffffu);
            kv[t] = kv[t] * fexp(bsum - bq[t]);
        }
#pragma unroll
        for (int g = 0; g < 4; ++g) {
            v4u w; w.x = pk2(kv[permk(g, 0)], kv[permk(g, 1)]); w.y = pk2(kv[permk(g, 2)], kv[permk(g, 3)]); w.z = pk2(kv[permk(g, 4)], kv[permk(g, 5)]); w.w = pk2(kv[permk(g, 6)], kv[permk(g, 7)]);
            *(GAS v4u*)(hk + (((dk >> 4) * 64) + (dk & 15) + 16 * g) * 16) = w;
        }
#pragma unroll
        for (int g = 0; g < 4; ++g) {
            v4u w; w.x = ve[permk(g, 0)] | ((unsigned)ve[permk(g, 1)] << 16); w.y = ve[permk(g, 2)] | ((unsigned)ve[permk(g, 3)] << 16);
            w.z = ve[permk(g, 4)] | ((unsigned)ve[permk(g, 5)] << 16); w.w = ve[permk(g, 6)] | ((unsigned)ve[permk(g, 7)] << 16);
            *(GAS v4u*)(hv + (((dk >> 4) * 64) + (dk & 15) + 16 * g) * 16) = w;
        }
    }
    LDS_WAIT(); asm volatile("" ::: "memory");
    const int r = lane & 15, g = lane >> 4;
#pragma unroll
    for (int mt = 0; mt < 2; ++mt)
#pragma unroll
        for (int kb = 0; kb < 4; ++kb) {
            const LAS unsigned char* p = QL + (16 * mt + r) * 272 + (32 * kb + 4 * g) * 2;
            const v2u lo = *(const LAS v2u*)p, hi = *(const LAS v2u*)(p + 32);
            *(GAS v4u*)(hq + ((mt * 4 + kb) * 64 + lane) * 16) = (v4u){lo.x, lo.y, hi.x, hi.y};
        }
    f32x4 acc[2][2];
#pragma unroll
    for (int mt = 0; mt < 2; ++mt)
#pragma unroll
        for (int nt = 0; nt < 2; ++nt) acc[mt][nt] = (f32x4){0.f, 0.f, 0.f, 0.f};
#pragma unroll
    for (int ks = 0; ks < 4; ++ks) {
        bf16x8 af[2], bfr[2];
#pragma unroll
        for (int mt = 0; mt < 2; ++mt) { af[mt] = *(const LAS bf16x8*)(QL + (16 * mt + r) * 272 + (32 * ks + 8 * g) * 2); bfr[mt] = *(const LAS bf16x8*)(KL + (16 * mt + r) * 272 + (32 * ks + 8 * g) * 2); }
#pragma unroll
        for (int mt = 0; mt < 2; ++mt)
#pragma unroll
            for (int nt = 0; nt < 2; ++nt) acc[mt][nt] = __builtin_amdgcn_mfma_f32_16x16x32_bf16(af[mt], bfr[nt], acc[mt][nt], 0, 0, 0);
    }
    LDS_WAIT(); asm volatile("" ::: "memory");
#pragma unroll
    for (int mt = 0; mt < 2; ++mt)
#pragma unroll
        for (int nt = 0; nt < 2; ++nt)
#pragma unroll
            for (int i = 0; i < 4; ++i) { const int t = 16 * mt + 4 * g + i, s = 16 * nt + r;
                *(LAS bf16*)(KL + t * 80 + s * 2) = (bf16)(pk2(s <= t ? acc[mt][nt][i] : 0.f, 0.f) & 0xffffu); }
    LDS_WAIT(); asm volatile("" ::: "memory");
#pragma unroll
    for (int mt = 0; mt < 2; ++mt) {
        const LAS unsigned char* p = KL + (16 * mt + r) * 80 + (4 * g) * 2;
        const v2u lo = *(const LAS v2u*)p, hi = *(const LAS v2u*)(p + 32);
        *(GAS v4u*)(ha + (mt * 64 + lane) * 16) = (v4u){lo.x, lo.y, hi.x, hi.y};
    }
    LDS_WAIT(); asm volatile("" ::: "memory");
}

DI void gate_pass(const Frame& F, int layer) {
    const bf16* P = (const bf16*)(F.ws + WS_P); bf16* GZ = (bf16*)(F.ws + WS_GZ);
    constexpr int NIT = 12 * SEQ * 8;
    int tid = F.tid; asm volatile("" : "+v"(tid));
    const int stride = F.G * 512;
#pragma unroll 1
    for (int i0 = (int)blockIdx.x * 512 + tid; i0 < NIT; i0 += 3 * stride) {
        v4u z[3][2]; f32x4 gn[3][4];
#pragma unroll
        for (int j = 0; j < 3; ++j) {
            const int idx = i0 + j * stride;
            if (idx < NIT) {
                const int rowid = idx >> 3, cg = idx & 7, bh = rowid / SEQ, t = rowid - bh * SEQ, b = bh / 6, h = bh - 6 * b;
                const bf16* src = P + ((size_t)b * SEQ + t) * NP + PC_Z + h * 128 + 16 * cg;
                const float* gp = F.in[18] + layer * 128 + 16 * cg;
                z[j][0] = *(const GAS v4u*)src; z[j][1] = *(const GAS v4u*)(src + 8);
#pragma unroll
                for (int q = 0; q < 4; ++q) gn[j][q] = *(const GAS f32x4*)(gp + 4 * q);
            }
        }
        __builtin_amdgcn_sched_barrier(0);
#pragma unroll
        for (int j = 0; j < 3; ++j) {
            const int idx = i0 + j * stride;
            if (idx < NIT) {
#pragma unroll
                for (int hlf = 0; hlf < 2; ++hlf) {
                    const v4u zz = z[j][hlf]; const f32x4 ga = gn[j][2 * hlf], gb = gn[j][2 * hlf + 1];
                    v4u o;
                    o.x = pk2(silu(bflo(zz.x)) * ga.x, silu(bfhi(zz.x)) * ga.y); o.y = pk2(silu(bflo(zz.y)) * ga.z, silu(bfhi(zz.y)) * ga.w);
                    o.z = pk2(silu(bflo(zz.z)) * gb.x, silu(bfhi(zz.z)) * gb.y); o.w = pk2(silu(bflo(zz.w)) * gb.z, silu(bfhi(zz.w)) * gb.w);
                    *(GAS v4u*)(GZ + (size_t)idx * 16 + 8 * hlf) = o;
                }
            }
        }
    }
}
namespace gp {
constexpr int KT = 0, QT = 17408, KBT = 34816, VBT = 53248, K2T = 71680, LM = 90112, TM = 107520, AT = 116736, SM = 125952, TF = 126976, XS = 144384, CW = 153088;
}
DI void gdn_prep_job(const Frame& F, int job, int layer, int variant = 0) {
    const int bh = job >> 6, ch = job & 63, b = bh / 6, h = bh % 6, tid = F.tid, lane = F.lane, wave = F.wave;
    const int t0 = ch * 64; const size_t m0 = (size_t)b * SEQ + t0;
    LAS unsigned char* L = F.lds;
    const bf16* P = (const bf16*)(F.ws + WS_P);
    const float* PBA = (const float*)(F.ws + WS_PBA);
    LAS float* BETA = (LAS float*)(L + gp::SM); LAS float* BC = BETA + 64;
    const size_t cidx = (size_t)bh * 64 + ch;
    if (tid < 384) { const int j = tid / 96, i96 = tid % 96, seg = i96 >> 5, c4 = (i96 & 31) * 4;
        const f32x4 cwv = *(const GAS f32x4*)(F.in[15] + ((size_t)layer * 4 + j) * 2304 + seg * 768 + h * 128 + c4);
        *(LAS f32x4*)(L + gp::CW + (j * 384 + seg * 128 + c4) * 4) = cwv; }
    if (wave == 0) {
        const float* pba = PBA + (m0 + lane) * 16;
        const float beta = sigm(pba[h]);
        float g = -fexp(F.in[16][layer * 6 + h]) * softplus(pba[6 + h] + F.in[17][layer * 6 + h]);
#pragma unroll
        for (int o = 1; o < 64; o <<= 1) { const float v = __shfl_up(g, o); if (lane >= o) g += v; }
        const float blast = __shfl(g, 63);
        BETA[lane] = beta; BC[lane] = g;
        if (lane == 0) { BC[64] = blast; ((float*)(F.ws + WS_GE))[cidx] = fexp(blast); }
    }
    LDS_WAIT(); __syncthreads();
    const float blast = BC[64];
        const int t2 = tid >> 3, c02 = 16 * (tid & 7);
        const int pcol2 = PC_V + h * 128 + c02, wch2 = 1536 + h * 128 + c02;
        float av[16];
#pragma unroll
        for (int c = 0; c < 16; ++c) av[c] = 0.f;
        v4u xv[4][2];
#pragma unroll
        for (int j = 0; j < 4; ++j) {
            const int tt = t0 + t2 - 3 + j;
            if (tt >= 0) { const bf16* src = P + ((size_t)b * SEQ + tt) * NP + pcol2; xv[j][0] = *(const GAS v4u*)src; xv[j][1] = *(const GAS v4u*)(src + 8); }
        }
#pragma unroll
        for (int j = 0; j < 4; ++j) {
            const int tt = t0 + t2 - 3 + j;
            if (tt >= 0) {
                const LAS float* wp = (const LAS float*)(L + gp::CW) + j * 384 + 256 + c02;
#pragma unroll
                for (int q4 = 0; q4 < 2; ++q4) {
                    const v4u x = xv[j][q4]; const f32x4 w0 = *(const LAS f32x4*)(wp + 8 * q4), w1 = *(const LAS f32x4*)(wp + 8 * q4 + 4);
                    av[8 * q4 + 0] += bflo(x.x) * w0.x; av[8 * q4 + 1] += bfhi(x.x) * w0.y; av[8 * q4 + 2] += bflo(x.y) * w0.z; av[8 * q4 + 3] += bfhi(x.y) * w0.w;
                    av[8 * q4 + 4] += bflo(x.z) * w1.x; av[8 * q4 + 5] += bfhi(x.z) * w1.y; av[8 * q4 + 6] += bflo(x.w) * w1.z; av[8 * q4 + 7] += bfhi(x.w) * w1.w;
                }
            }
        }
    if (!(variant & 2)) {
        const int t = tid >> 3, isk = (tid >> 2) & 1, part = tid & 3, c0 = 32 * part;
        const int pcol = (isk ? PC_K : PC_Q) + h * 128 + c0, wch = (isk ? 768 : 0) + h * 128 + c0;
        float a[32];
#pragma unroll
        for (int c = 0; c < 32; ++c) a[c] = 0.f;
        v4u xq[4][4];
#pragma unroll
        for (int j = 0; j < 4; ++j) {
            const int tt = t0 + t - 3 + j;
            if (tt >= 0) { const bf16* src = P + ((size_t)b * SEQ + tt) * NP + pcol;
#pragma unroll
                for (int q4 = 0; q4 < 4; ++q4) xq[j][q4] = *(const GAS v4u*)(src + 8 * q4); }
        }
#pragma unroll
        for (int j = 0; j < 4; ++j) {
            const int tt = t0 + t - 3 + j;
            if (tt >= 0) {
                const LAS float* wp = (const LAS float*)(L + gp::CW) + j * 384 + isk * 128 + c0;
#pragma unroll
                for (int q4 = 0; q4 < 4; ++q4) {
                    const v4u x = xq[j][q4]; const f32x4 w0 = *(const LAS f32x4*)(wp + 8 * q4), w1 = *(const LAS f32x4*)(wp + 8 * q4 + 4);
                    a[8 * q4 + 0] += bflo(x.x) * w0.x; a[8 * q4 + 1] += bfhi(x.x) * w0.y; a[8 * q4 + 2] += bflo(x.y) * w0.z; a[8 * q4 + 3] += bfhi(x.y) * w0.w;
                    a[8 * q4 + 4] += bflo(x.z) * w1.x; a[8 * q4 + 5] += bfhi(x.z) * w1.y; a[8 * q4 + 6] += bflo(x.w) * w1.z; a[8 * q4 + 7] += bfhi(x.w) * w1.w;
                }
            }
        }
        float ss = 0.f;
#pragma unroll
        for (int c = 0; c < 32; ++c) { a[c] = silu(a[c]); ss += a[c] * a[c]; }
        ss += __shfl_xor(ss, 1); ss += __shfl_xor(ss, 2);
        const float rinv = frsq(ss + 1e-6f);
        const float bct = BC[t], ebc = fexp(bct);
        if (!isk) {
            const float sc = rinv * 0.08838834764831845f;
#pragma unroll
            for (int c = 0; c < 32; ++c) a[c] *= sc;
#pragma unroll
            for (int q4 = 0; q4 < 4; ++q4) { v4u w; w.x = pk2(a[8 * q4], a[8 * q4 + 1]); w.y = pk2(a[8 * q4 + 2], a[8 * q4 + 3]); w.z = pk2(a[8 * q4 + 4], a[8 * q4 + 5]); w.w = pk2(a[8 * q4 + 6], a[8 * q4 + 7]);
                *(LAS v4u*)(L + gp::QT + t * 272 + (c0 + 8 * q4) * 2) = w; }
            unsigned char* gq = F.ws + WS_GQ + cidx * 16384 + (size_t)(((t >> 4) * 4 + part) * 64 + (t & 15)) * 16;
#pragma unroll
            for (int g = 0; g < 4; ++g) { v4u w; w.x = pk2(a[permk(g, 0)] * ebc, a[permk(g, 1)] * ebc); w.y = pk2(a[permk(g, 2)] * ebc, a[permk(g, 3)] * ebc);
                w.z = pk2(a[permk(g, 4)] * ebc, a[permk(g, 5)] * ebc); w.w = pk2(a[permk(g, 6)] * ebc, a[permk(g, 7)] * ebc);
                *(GAS v4u*)(gq + g * 256) = w; }
        } else {
#pragma unroll
            for (int c = 0; c < 32; ++c) a[c] *= rinv;
#pragma unroll
            for (int q4 = 0; q4 < 4; ++q4) { v4u w; w.x = pk2(a[8 * q4], a[8 * q4 + 1]); w.y = pk2(a[8 * q4 + 2], a[8 * q4 + 3]); w.z = pk2(a[8 * q4 + 4], a[8 * q4 + 5]); w.w = pk2(a[8 * q4 + 6], a[8 * q4 + 7]);
                *(LAS v4u*)(L + gp::KT + t * 272 + (c0 + 8 * q4) * 2) = w; }
            const float s1 = BETA[t] * ebc, s2 = fexp(blast - bct);
#pragma unroll
            for (int c = 0; c < 32; ++c) {
                *(LAS bf16*)(L + gp::KBT + (c0 + c) * 144 + t * 2) = (bf16)(pk2(a[c] * s1, 0.f) & 0xffffu);
                *(LAS bf16*)(L + gp::K2T + (c0 + c) * 144 + t * 2) = (bf16)(pk2(a[c] * s2, 0.f) & 0xffffu);
            }
        }
    }
    {
        const float bt = BETA[t2];
#pragma unroll
        for (int c = 0; c < 16; ++c) *(LAS bf16*)(L + gp::VBT + (c02 + c) * 144 + t2 * 2) = (bf16)(pk2(silu(av[c]) * bt, 0.f) & 0xffffu);
    }
    LDS_WAIT(); __syncthreads();
    const int r = lane & 15, g = lane >> 4;
#pragma unroll 1
    for (int idx = 0; idx < 4; ++idx) {
        const int jb = 4 * wave + idx, type = jb >> 4, ti = (jb >> 2) & 3, tj = jb & 3;
        if (tj > ti) {
            if (type == 1) {
#pragma unroll
                for (int e = 0; e < 4; ++e) *(LAS bf16*)(L + gp::AT + (16 * ti + 4 * g + e) * 144 + (16 * tj + r) * 2) = (bf16)0;
            }
            continue;
        }
        f32x4 acc = {0.f, 0.f, 0.f, 0.f};
        const LAS unsigned char* pa = L + (type ? gp::QT : gp::KT) + (16 * ti + r) * 272 + 16 * g;
        const LAS unsigned char* pb = L + gp::KT + (16 * tj + r) * 272 + 16 * g;
#pragma unroll
        for (int ks = 0; ks < 4; ++ks) acc = __builtin_amdgcn_mfma_f32_16x16x32_bf16(*(const LAS bf16x8*)(pa + 64 * ks), *(const LAS bf16x8*)(pb + 64 * ks), acc, 0, 0, 0);
        const int j = 16 * tj + r; const float bcj = BC[j];
#pragma unroll
        for (int e = 0; e < 4; ++e) {
            const int i = 16 * ti + 4 * g + e; const float dec = fexp(BC[i] - bcj);
            if (type == 0) ((LAS float*)(L + gp::LM))[i * 68 + j] = (i > j) ? BETA[i] * acc[e] * dec : 0.f;
            else *(LAS bf16*)(L + gp::AT + i * 144 + j * 2) = (bf16)(pk2((i >= j) ? acc[e] * dec : 0.f, 0.f) & 0xffffu);
        }
    }
    LDS_WAIT(); __syncthreads();
    {
        LAS float* LMp = (LAS float*)(L + gp::LM); LAS float* TF = (LAS float*)(L + gp::TF); LAS float* XS = (LAS float*)(L + gp::XS) + wave * 272;
        if (wave == 0 && !(variant & 1)) {
            const int bk = lane >> 4, c = lane & 15; const float fc = (float)c;
            float t[16];
#pragma unroll
            for (int i = 0; i < 16; ++i) {
                float acc = fmaxf(0.f, 1.f - fabsf(fc - (float)i));
#pragma unroll
                for (int jj = 0; jj < (i + 3) / 4; ++jj) {
                    const f32x4 l4 = *(const LAS f32x4*)(LMp + (16 * bk + i) * 68 + 16 * bk + 4 * jj);
#pragma unroll
                    for (int e = 0; e < 4; ++e) if (4 * jj + e < i) acc -= l4[e] * t[4 * jj + e];
                }
                t[i] = acc;
                TF[(16 * bk + i) * 68 + 16 * bk + c] = acc;
            }
        } else if (wave != 0) {
            unsigned char* gk = F.ws + WS_GK + cidx * 16384; unsigned char* ga = F.ws + WS_GA + cidx * 8192;
            for (int task = tid - 64; task < 1536; task += 448) {
                const bool isa = task >= 1024; const int t2 = isa ? task - 1024 : task, blk = t2 >> 6, ln = t2 & 63, rr = ln & 15, gg = ln >> 4, mt = blk >> 1, kb = blk & 1;
                const LAS unsigned char* p = L + (isa ? gp::AT : gp::K2T) + (16 * mt + rr) * 144 + (32 * kb + 4 * gg) * 2;
                const v2u lo = *(const LAS v2u*)p, hi = *(const LAS v2u*)(p + 32);
                *(GAS v4u*)((isa ? ga : gk) + (size_t)(blk * 64 + ln) * 16) = (v4u){lo.x, lo.y, hi.x, hi.y};
            }
        }
        LDS_WAIT(); __syncthreads();
#pragma unroll 1
        for (int d = 1; d < 4; ++d) {
            if (wave < 4 - d) {
                const int bj = wave, bi = wave + d;
                f32x4 x = {0.f, 0.f, 0.f, 0.f};
                for (int k = bj; k < bi; ++k) {
#pragma unroll
                    for (int s4 = 0; s4 < 4; ++s4) {
                        const float av = LMp[(16 * bi + r) * 68 + 16 * k + 4 * s4 + g];
                        const float bv = TF[(16 * k + 4 * s4 + g) * 68 + 16 * bj + r];
                        x = __builtin_amdgcn_mfma_f32_16x16x4f32(av, bv, x, 0, 0, 0);
                    }
                }
#pragma unroll
                for (int e = 0; e < 4; ++e) XS[(4 * g + e) * 17 + r] = x[e];
                LDS_WAIT(); asm volatile("" ::: "memory");
                f32x4 y = {0.f, 0.f, 0.f, 0.f};
#pragma unroll
                for (int s4 = 0; s4 < 4; ++s4) {
                    const float av = TF[(16 * bi + r) * 68 + 16 * bi + 4 * s4 + g];
                    const float bv = XS[(4 * s4 + g) * 17 + r];
                    y = __builtin_amdgcn_mfma_f32_16x16x4f32(av, bv, y, 0, 0, 0);
                }
#pragma unroll
                for (int e = 0; e < 4; ++e) TF[(16 * bi + 4 * g + e) * 68 + 16 * bj + r] = -y[e];
            }
            LDS_WAIT(); __syncthreads();
        }
        {
            const int row = tid >> 3, c0 = 8 * (tid & 7);
            f32x4 v0 = *(const LAS f32x4*)(TF + row * 68 + c0), v1 = *(const LAS f32x4*)(TF + row * 68 + c0 + 4);
            if ((c0 >> 4) > (row >> 4)) { v0 = (f32x4){0.f, 0.f, 0.f, 0.f}; v1 = v0; }
            v4u w; w.x = pk2(v0.x, v0.y); w.y = pk2(v0.z, v0.w); w.z = pk2(v1.x, v1.y); w.w = pk2(v1.z, v1.w);
            *(LAS v4u*)(L + gp::TM + row * 144 + c0 * 2) = w;
        }
    }
    LDS_WAIT(); __syncthreads();
#pragma unroll 1
    for (int idx = 0; idx < 8; ++idx) {
        const int jb = 8 * wave + idx;
        if (jb < 32) {
            const int mt = jb >> 2, nt = jb & 3;
            f32x4 acc = {0.f, 0.f, 0.f, 0.f};
            const LAS unsigned char* pa = L + gp::KBT + (16 * mt + r) * 144 + 16 * g; const LAS unsigned char* pb = L + gp::TM + (16 * nt + r) * 144 + 16 * g;
#pragma unroll
            for (int ks = 0; ks < 2; ++ks) acc = __builtin_amdgcn_mfma_f32_16x16x32_bf16(*(const LAS bf16x8*)(pa + 64 * ks), *(const LAS bf16x8*)(pb + 64 * ks), acc, 0, 0, 0);
            v2u w; w.x = pk2(acc[0], acc[1]); w.y = pk2(acc[2], acc[3]);
            *(GAS v2u*)(F.ws + WS_GW + cidx * 16384 + (size_t)((nt * 4 + (mt >> 1)) * 64 + lane) * 16 + 8 * (mt & 1)) = w;
        } else {
            const int j2 = jb - 32, mt = j2 >> 3, nt = j2 & 7;
            f32x4 acc = {0.f, 0.f, 0.f, 0.f};
            const LAS unsigned char* pa = L + gp::TM + (16 * mt + r) * 144 + 16 * g; const LAS unsigned char* pb = L + gp::VBT + (16 * nt + r) * 144 + 16 * g;
#pragma unroll
            for (int ks = 0; ks < 2; ++ks) acc = __builtin_amdgcn_mfma_f32_16x16x32_bf16(*(const LAS bf16x8*)(pa + 64 * ks), *(const LAS bf16x8*)(pb + 64 * ks), acc, 0, 0, 0);
            { v2u w; w.x = pk2(acc[0], acc[1]); w.y = pk2(acc[2], acc[3]); *(GAS v2u*)(F.ws + WS_GU + cidx * 16384 + (size_t)((nt * 4 + mt) * 64 + lane) * 8) = w; }
        }
    }
    LDS_WAIT(); __syncthreads();
}
DI void copy_g2l(LAS unsigned char* dst, const unsigned char* src, int bytes, int tid) {
    for (int o = tid * 16; o < bytes; o += 512 * 16) *(LAS v4u*)(dst + o) = *(const GAS v4u*)(src + o);
}
DI bf16x8 pack_b(const f32x4& lo, const f32x4& hi) {
    v4u w; w.x = pk2(lo[0], lo[1]); w.y = pk2(lo[2], lo[3]); w.z = pk2(hi[0], hi[1]); w.w = pk2(hi[2], hi[3]);
    return __builtin_bit_cast(bf16x8, w);
}
#define BAR_LDS() do { asm volatile("s_waitcnt lgkmcnt(0)" ::: "memory"); __builtin_amdgcn_s_barrier(); asm volatile("" ::: "memory"); } while (0)
#define MFMA16(a, b, c) __builtin_amdgcn_mfma_f32_16x16x32_bf16((a), (b), (c), 0, 0, 0)

#define BAR_RAW() do { asm volatile("s_waitcnt lgkmcnt(0)" ::: "memory"); __builtin_amdgcn_s_barrier(); asm volatile("" ::: "memory"); } while (0)

DI void gdn_scan(const Frame& F, int bh, int layer, int variant = 0) {
    const int b = bh / 6, h = bh % 6, tid = F.tid, lane = F.lane, wave = F.wave, r = lane & 15, g = lane >> 4;
    LAS unsigned char* L = F.lds;
    constexpr int BUF = 57344, OT = 114688;
    const unsigned char* gw = F.ws + WS_GW + (size_t)bh * 64 * 16384; const unsigned char* gq = F.ws + WS_GQ + (size_t)bh * 64 * 16384;
    const unsigned char* gk = F.ws + WS_GK + (size_t)bh * 64 * 16384; const unsigned char* ga = F.ws + WS_GA + (size_t)bh * 64 * 8192;
    const unsigned char* gu = F.ws + WS_GU + (size_t)bh * 64 * 16384; const float* ge = (const float*)(F.ws + WS_GE) + (size_t)bh * 64;
    copy_g2l(L, gw, 16384, tid); copy_g2l(L + 16384, gq, 16384, tid); copy_g2l(L + 32768, gk, 16384, tid); copy_g2l(L + 49152, ga, 8192, tid);
    BAR_RAW();
    if (wave < 4) {
        f32x4 S[2][8];
#pragma unroll
        for (int n = 0; n < 2; ++n)
#pragma unroll
            for (int i = 0; i < 8; ++i) S[n][i] = (f32x4){0.f, 0.f, 0.f, 0.f};
        float ebs = ge[lane];
        asm volatile("" : "+v"(ebs));
        v2u ua[2][4], ub[2][4];
#pragma unroll
        for (int n = 0; n < 2; ++n)
#pragma unroll
            for (int mt = 0; mt < 4; ++mt) ua[n][mt] = *(const GAS v2u*)(gu + (size_t)(((2 * wave + n) * 4 + mt) * 64 + lane) * 8);
#pragma unroll 1
        for (int c2 = 0; c2 < 64; c2 += 2) {
        {
            const int ch = c2;
            LAS unsigned char* B0 = L + (ch & 1) * BUF;
            const int cn = (ch + 1 < 64) ? ch + 1 : ch;
#pragma unroll
            for (int n = 0; n < 2; ++n)
#pragma unroll
                for (int mt = 0; mt < 4; ++mt) ub[n][mt] = *(const GAS v2u*)(gu + (size_t)cn * 16384 + (size_t)(((2 * wave + n) * 4 + mt) * 64 + lane) * 8);
            const float eb = __builtin_bit_cast(float, __builtin_amdgcn_readlane(__builtin_bit_cast(int, ebs), ch));
            __builtin_amdgcn_sched_barrier(0);
            bf16x8 Sb[2][4];
#pragma unroll
            for (int n = 0; n < 2; ++n)
#pragma unroll
                for (int kb = 0; kb < 4; ++kb) Sb[n][kb] = pack_b(S[n][2 * kb], S[n][2 * kb + 1]);
            const LAS unsigned char* B0l = B0 + lane * 16;
            bf16x8 fr0[4], fr1[4];
            f32x4 o[2][4], vn[2][4]; bf16x8 Vb[2][2];
#pragma unroll
            for (int n = 0; n < 2; ++n)
#pragma unroll
                for (int mt = 0; mt < 4; ++mt) o[n][mt] = (f32x4){0.f, 0.f, 0.f, 0.f};
            if (!(variant & 2)) {
            fr0[0] = *(const LAS bf16x8*)(B0l + 16384 + 0*1024 + 0*1024); fr0[1] = *(const LAS bf16x8*)(B0l + 16384 + 0*1024 + 1*1024); fr0[2] = *(const LAS bf16x8*)(B0l + 16384 + 0*1024 + 2*1024); fr0[3] = *(const LAS bf16x8*)(B0l + 16384 + 0*1024 + 3*1024);
            fr1[0] = *(const LAS bf16x8*)(B0l + 16384 + 4*1024 + 0*1024); fr1[1] = *(const LAS bf16x8*)(B0l + 16384 + 4*1024 + 1*1024); fr1[2] = *(const LAS bf16x8*)(B0l + 16384 + 4*1024 + 2*1024); fr1[3] = *(const LAS bf16x8*)(B0l + 16384 + 4*1024 + 3*1024);
            __builtin_amdgcn_sched_barrier(0);
            { f32x4 c0 = {0.f, 0.f, 0.f, 0.f}, c1 = {0.f, 0.f, 0.f, 0.f};
              c0 = MFMA16(fr0[0], Sb[0][0], c0); c1 = MFMA16(fr0[0], Sb[1][0], c1);
              c0 = MFMA16(fr0[1], Sb[0][1], c0); c1 = MFMA16(fr0[1], Sb[1][1], c1);
              c0 = MFMA16(fr0[2], Sb[0][2], c0); c1 = MFMA16(fr0[2], Sb[1][2], c1);
              c0 = MFMA16(fr0[3], Sb[0][3], c0); c1 = MFMA16(fr0[3], Sb[1][3], c1);
              o[0][0] = c0; o[1][0] = c1; }
            __builtin_amdgcn_sched_barrier(0);
            fr0[0] = *(const LAS bf16x8*)(B0l + 16384 + 8*1024 + 0*1024); fr0[1] = *(const LAS bf16x8*)(B0l + 16384 + 8*1024 + 1*1024); fr0[2] = *(const LAS bf16x8*)(B0l + 16384 + 8*1024 + 2*1024); fr0[3] = *(const LAS bf16x8*)(B0l + 16384 + 8*1024 + 3*1024);
            __builtin_amdgcn_sched_barrier(0);
            { f32x4 c0 = {0.f, 0.f, 0.f, 0.f}, c1 = {0.f, 0.f, 0.f, 0.f};
              c0 = MFMA16(fr1[0], Sb[0][0], c0); c1 = MFMA16(fr1[0], Sb[1][0], c1);
              c0 = MFMA16(fr1[1], Sb[0][1], c0); c1 = MFMA16(fr1[1], Sb[1][1], c1);
              c0 = MFMA16(fr1[2], Sb[0][2], c0); c1 = MFMA16(fr1[2], Sb[1][2], c1);
              c0 = MFMA16(fr1[3], Sb[0][3], c0); c1 = MFMA16(fr1[3], Sb[1][3], c1);
              o[0][1] = c0; o[1][1] = c1; }
            __builtin_amdgcn_sched_barrier(0);
            fr1[0] = *(const LAS bf16x8*)(B0l + 16384 + 12*1024 + 0*1024); fr1[1] = *(const LAS bf16x8*)(B0l + 16384 + 12*1024 + 1*1024); fr1[2] = *(const LAS bf16x8*)(B0l + 16384 + 12*1024 + 2*1024); fr1[3] = *(const LAS bf16x8*)(B0l + 16384 + 12*1024 + 3*1024);
            __builtin_amdgcn_sched_barrier(0);
            { f32x4 c0 = {0.f, 0.f, 0.f, 0.f}, c1 = {0.f, 0.f, 0.f, 0.f};
              c0 = MFMA16(fr0[0], Sb[0][0], c0); c1 = MFMA16(fr0[0], Sb[1][0], c1);
              c0 = MFMA16(fr0[1], Sb[0][1], c0); c1 = MFMA16(fr0[1], Sb[1][1], c1);
              c0 = MFMA16(fr0[2], Sb[0][2], c0); c1 = MFMA16(fr0[2], Sb[1][2], c1);
              c0 = MFMA16(fr0[3], Sb[0][3], c0); c1 = MFMA16(fr0[3], Sb[1][3], c1);
              o[0][2] = c0; o[1][2] = c1; }
            __builtin_amdgcn_sched_barrier(0);
            fr0[0] = *(const LAS bf16x8*)(B0l + 0*1024 + 0*1024); fr0[1] = *(const LAS bf16x8*)(B0l + 0*1024 + 1*1024); fr0[2] = *(const LAS bf16x8*)(B0l + 0*1024 + 2*1024); fr0[3] = *(const LAS bf16x8*)(B0l + 0*1024 + 3*1024);
            __builtin_amdgcn_sched_barrier(0);
            { f32x4 c0 = {0.f, 0.f, 0.f, 0.f}, c1 = {0.f, 0.f, 0.f, 0.f};
              c0 = MFMA16(fr1[0], Sb[0][0], c0); c1 = MFMA16(fr1[0], Sb[1][0], c1);
              c0 = MFMA16(fr1[1], Sb[0][1], c0); c1 = MFMA16(fr1[1], Sb[1][1], c1);
              c0 = MFMA16(fr1[2], Sb[0][2], c0); c1 = MFMA16(fr1[2], Sb[1][2], c1);
              c0 = MFMA16(fr1[3], Sb[0][3], c0); c1 = MFMA16(fr1[3], Sb[1][3], c1);
              o[0][3] = c0; o[1][3] = c1; }
            __builtin_amdgcn_sched_barrier(0);
            fr1[0] = *(const LAS bf16x8*)(B0l + 4*1024 + 0*1024); fr1[1] = *(const LAS bf16x8*)(B0l + 4*1024 + 1*1024); fr1[2] = *(const LAS bf16x8*)(B0l + 4*1024 + 2*1024); fr1[3] = *(const LAS bf16x8*)(B0l + 4*1024 + 3*1024);
            __builtin_amdgcn_sched_barrier(0);
            { f32x4 a0 = {0.f, 0.f, 0.f, 0.f}, a1 = {0.f, 0.f, 0.f, 0.f};
              a0 = MFMA16(fr0[0], Sb[0][0], a0); a1 = MFMA16(fr0[0], Sb[1][0], a1);
              a0 = MFMA16(fr0[1], Sb[0][1], a0); a1 = MFMA16(fr0[1], Sb[1][1], a1);
              a0 = MFMA16(fr0[2], Sb[0][2], a0); a1 = MFMA16(fr0[2], Sb[1][2], a1);
              a0 = MFMA16(fr0[3], Sb[0][3], a0); a1 = MFMA16(fr0[3], Sb[1][3], a1);
              vn[0][0] = (f32x4){bflo(ua[0][0].x), bfhi(ua[0][0].x), bflo(ua[0][0].y), bfhi(ua[0][0].y)} - a0; vn[1][0] = (f32x4){bflo(ua[1][0].x), bfhi(ua[1][0].x), bflo(ua[1][0].y), bfhi(ua[1][0].y)} - a1; }
            __builtin_amdgcn_sched_barrier(0);
            fr0[0] = *(const LAS bf16x8*)(B0l + 8*1024 + 0*1024); fr0[1] = *(const LAS bf16x8*)(B0l + 8*1024 + 1*1024); fr0[2] = *(const LAS bf16x8*)(B0l + 8*1024 + 2*1024); fr0[3] = *(const LAS bf16x8*)(B0l + 8*1024 + 3*1024);
            __builtin_amdgcn_sched_barrier(0);
            { f32x4 a0 = {0.f, 0.f, 0.f, 0.f}, a1 = {0.f, 0.f, 0.f, 0.f};
              a0 = MFMA16(fr1[0], Sb[0][0], a0); a1 = MFMA16(fr1[0], Sb[1][0], a1);
              a0 = MFMA16(fr1[1], Sb[0][1], a0); a1 = MFMA16(fr1[1], Sb[1][1], a1);
              a0 = MFMA16(fr1[2], Sb[0][2], a0); a1 = MFMA16(fr1[2], Sb[1][2], a1);
              a0 = MFMA16(fr1[3], Sb[0][3], a0); a1 = MFMA16(fr1[3], Sb[1][3], a1);
              vn[0][1] = (f32x4){bflo(ua[0][1].x), bfhi(ua[0][1].x), bflo(ua[0][1].y), bfhi(ua[0][1].y)} - a0; vn[1][1] = (f32x4){bflo(ua[1][1].x), bfhi(ua[1][1].x), bflo(ua[1][1].y), bfhi(ua[1][1].y)} - a1; }
            __builtin_amdgcn_sched_barrier(0);
            fr1[0] = *(const LAS bf16x8*)(B0l + 12*1024 + 0*1024); fr1[1] = *(const LAS bf16x8*)(B0l + 12*1024 + 1*1024); fr1[2] = *(const LAS bf16x8*)(B0l + 12*1024 + 2*1024); fr1[3] = *(const LAS bf16x8*)(B0l + 12*1024 + 3*1024);
            __builtin_amdgcn_sched_barrier(0);
            { f32x4 a0 = {0.f, 0.f, 0.f, 0.f}, a1 = {0.f, 0.f, 0.f, 0.f};
              a0 = MFMA16(fr0[0], Sb[0][0], a0); a1 = MFMA16(fr0[0], Sb[1][0], a1);
              a0 = MFMA16(fr0[1], Sb[0][1], a0); a1 = MFMA16(fr0[1], Sb[1][1], a1);
              a0 = MFMA16(fr0[2], Sb[0][2], a0); a1 = MFMA16(fr0[2], Sb[1][2], a1);
              a0 = MFMA16(fr0[3], Sb[0][3], a0); a1 = MFMA16(fr0[3], Sb[1][3], a1);
              vn[0][2] = (f32x4){bflo(ua[0][2].x), bfhi(ua[0][2].x), bflo(ua[0][2].y), bfhi(ua[0][2].y)} - a0; vn[1][2] = (f32x4){bflo(ua[1][2].x), bfhi(ua[1][2].x), bflo(ua[1][2].y), bfhi(ua[1][2].y)} - a1; }
            __builtin_amdgcn_sched_barrier(0);
            fr0[0] = *(const LAS bf16x8*)(B0l + 49152 + 0*1024 + 0*1024); fr0[1] = *(const LAS bf16x8*)(B0l + 49152 + 0*1024 + 1*1024);
            __builtin_amdgcn_sched_barrier(0);
            { f32x4 a0 = {0.f, 0.f, 0.f, 0.f}, a1 = {0.f, 0.f, 0.f, 0.f};
              a0 = MFMA16(fr1[0], Sb[0][0], a0); a1 = MFMA16(fr1[0], Sb[1][0], a1);
              a0 = MFMA16(fr1[1], Sb[0][1], a0); a1 = MFMA16(fr1[1], Sb[1][1], a1);
              a0 = MFMA16(fr1[2], Sb[0][2], a0); a1 = MFMA16(fr1[2], Sb[1][2], a1);
              a0 = MFMA16(fr1[3], Sb[0][3], a0); a1 = MFMA16(fr1[3], Sb[1][3], a1);
              vn[0][3] = (f32x4){bflo(ua[0][3].x), bfhi(ua[0][3].x), bflo(ua[0][3].y), bfhi(ua[0][3].y)} - a0; vn[1][3] = (f32x4){bflo(ua[1][3].x), bfhi(ua[1][3].x), bflo(ua[1][3].y), bfhi(ua[1][3].y)} - a1; }
            Vb[0][0] = pack_b(vn[0][0], vn[0][1]); Vb[0][1] = pack_b(vn[0][2], vn[0][3]); Vb[1][0] = pack_b(vn[1][0], vn[1][1]); Vb[1][1] = pack_b(vn[1][2], vn[1][3]);
            __builtin_amdgcn_sched_barrier(0);
            fr1[0] = *(const LAS bf16x8*)(B0l + 49152 + 2*1024 + 0*1024); fr1[1] = *(const LAS bf16x8*)(B0l + 49152 + 2*1024 + 1*1024);
            __builtin_amdgcn_sched_barrier(0);
            o[0][0] = MFMA16(fr0[0], Vb[0][0], o[0][0]); o[1][0] = MFMA16(fr0[0], Vb[1][0], o[1][0]);
            o[0][0] = MFMA16(fr0[1], Vb[0][1], o[0][0]); o[1][0] = MFMA16(fr0[1], Vb[1][1], o[1][0]);
            __builtin_amdgcn_sched_barrier(0);
            fr0[0] = *(const LAS bf16x8*)(B0l + 49152 + 4*1024 + 0*1024); fr0[1] = *(const LAS bf16x8*)(B0l + 49152 + 4*1024 + 1*1024);
            __builtin_amdgcn_sched_barrier(0);
            o[0][1] = MFMA16(fr1[0], Vb[0][0], o[0][1]); o[1][1] = MFMA16(fr1[0], Vb[1][0], o[1][1]);
            o[0][1] = MFMA16(fr1[1], Vb[0][1], o[0][1]); o[1][1] = MFMA16(fr1[1], Vb[1][1], o[1][1]);
            __builtin_amdgcn_sched_barrier(0);
            fr1[0] = *(const LAS bf16x8*)(B0l + 49152 + 6*1024 + 0*1024); fr1[1] = *(const LAS bf16x8*)(B0l + 49152 + 6*1024 + 1*1024);
            __builtin_amdgcn_sched_barrier(0);
            o[0][2] = MFMA16(fr0[0], Vb[0][0], o[0][2]); o[1][2] = MFMA16(fr0[0], Vb[1][0], o[1][2]);
            o[0][2] = MFMA16(fr0[1], Vb[0][1], o[0][2]); o[1][2] = MFMA16(fr0[1], Vb[1][1], o[1][2]);
            __builtin_amdgcn_sched_barrier(0);
            fr0[0] = *(const LAS bf16x8*)(B0l + 32768 + 0*1024 + 0*1024); fr0[1] = *(const LAS bf16x8*)(B0l + 32768 + 0*1024 + 1*1024);
            __builtin_amdgcn_sched_barrier(0);
            o[0][3] = MFMA16(fr1[0], Vb[0][0], o[0][3]); o[1][3] = MFMA16(fr1[0], Vb[1][0], o[1][3]);
            o[0][3] = MFMA16(fr1[1], Vb[0][1], o[0][3]); o[1][3] = MFMA16(fr1[1], Vb[1][1], o[1][3]);
            __builtin_amdgcn_sched_barrier(0);
            fr1[0] = *(const LAS bf16x8*)(B0l + 32768 + 2*1024 + 0*1024); fr1[1] = *(const LAS bf16x8*)(B0l + 32768 + 2*1024 + 1*1024);
            __builtin_amdgcn_sched_barrier(0);
            { f32x4 a0 = S[0][0] * eb, a1 = S[1][0] * eb;
              a0 = MFMA16(fr0[0], Vb[0][0], a0); a1 = MFMA16(fr0[0], Vb[1][0], a1);
              a0 = MFMA16(fr0[1], Vb[0][1], a0); a1 = MFMA16(fr0[1], Vb[1][1], a1);
              S[0][0] = a0; S[1][0] = a1; }
            __builtin_amdgcn_sched_barrier(0);
            fr0[0] = *(const LAS bf16x8*)(B0l + 32768 + 4*1024 + 0*1024); fr0[1] = *(const LAS bf16x8*)(B0l + 32768 + 4*1024 + 1*1024);
            __builtin_amdgcn_sched_barrier(0);
            { f32x4 a0 = S[0][1] * eb, a1 = S[1][1] * eb;
              a0 = MFMA16(fr1[0], Vb[0][0], a0); a1 = MFMA16(fr1[0], Vb[1][0], a1);
              a0 = MFMA16(fr1[1], Vb[0][1], a0); a1 = MFMA16(fr1[1], Vb[1][1], a1);
              S[0][1] = a0; S[1][1] = a1; }
            __builtin_amdgcn_sched_barrier(0);
            fr1[0] = *(const LAS bf16x8*)(B0l + 32768 + 6*1024 + 0*1024); fr1[1] = *(const LAS bf16x8*)(B0l + 32768 + 6*1024 + 1*1024);
            __builtin_amdgcn_sched_barrier(0);
            { f32x4 a0 = S[0][2] * eb, a1 = S[1][2] * eb;
              a0 = MFMA16(fr0[0], Vb[0][0], a0); a1 = MFMA16(fr0[0], Vb[1][0], a1);
              a0 = MFMA16(fr0[1], Vb[0][1], a0); a1 = MFMA16(fr0[1], Vb[1][1], a1);
              S[0][2] = a0; S[1][2] = a1; }
            __builtin_amdgcn_sched_barrier(0);
            fr0[0] = *(const LAS bf16x8*)(B0l + 32768 + 8*1024 + 0*1024); fr0[1] = *(const LAS bf16x8*)(B0l + 32768 + 8*1024 + 1*1024);
            __builtin_amdgcn_sched_barrier(0);
            { f32x4 a0 = S[0][3] * eb, a1 = S[1][3] * eb;
              a0 = MFMA16(fr1[0], Vb[0][0], a0); a1 = MFMA16(fr1[0], Vb[1][0], a1);
              a0 = MFMA16(fr1[1], Vb[0][1], a0); a1 = MFMA16(fr1[1], Vb[1][1], a1);
              S[0][3] = a0; S[1][3] = a1; }
            __builtin_amdgcn_sched_barrier(0);
            fr1[0] = *(const LAS bf16x8*)(B0l + 32768 + 10*1024 + 0*1024); fr1[1] = *(const LAS bf16x8*)(B0l + 32768 + 10*1024 + 1*1024);
            __builtin_amdgcn_sched_barrier(0);
            { f32x4 a0 = S[0][4] * eb, a1 = S[1][4] * eb;
              a0 = MFMA16(fr0[0], Vb[0][0], a0); a1 = MFMA16(fr0[0], Vb[1][0], a1);
              a0 = MFMA16(fr0[1], Vb[0][1], a0); a1 = MFMA16(fr0[1], Vb[1][1], a1);
              S[0][4] = a0; S[1][4] = a1; }
            __builtin_amdgcn_sched_barrier(0);
            fr0[0] = *(const LAS bf16x8*)(B0l + 32768 + 12*1024 + 0*1024); fr0[1] = *(const LAS bf16x8*)(B0l + 32768 + 12*1024 + 1*1024);
            __builtin_amdgcn_sched_barrier(0);
            { f32x4 a0 = S[0][5] * eb, a1 = S[1][5] * eb;
              a0 = MFMA16(fr1[0], Vb[0][0], a0); a1 = MFMA16(fr1[0], Vb[1][0], a1);
              a0 = MFMA16(fr1[1], Vb[0][1], a0); a1 = MFMA16(fr1[1], Vb[1][1], a1);
              S[0][5] = a0; S[1][5] = a1; }
            __builtin_amdgcn_sched_barrier(0);
            fr1[0] = *(const LAS bf16x8*)(B0l + 32768 + 14*1024 + 0*1024); fr1[1] = *(const LAS bf16x8*)(B0l + 32768 + 14*1024 + 1*1024);
            __builtin_amdgcn_sched_barrier(0);
            { f32x4 a0 = S[0][6] * eb, a1 = S[1][6] * eb;
              a0 = MFMA16(fr0[0], Vb[0][0], a0); a1 = MFMA16(fr0[0], Vb[1][0], a1);
              a0 = MFMA16(fr0[1], Vb[0][1], a0); a1 = MFMA16(fr0[1], Vb[1][1], a1);
              S[0][6] = a0; S[1][6] = a1; }
            __builtin_amdgcn_sched_barrier(0);
            __builtin_amdgcn_sched_barrier(0);
            { f32x4 a0 = S[0][7] * eb, a1 = S[1][7] * eb;
              a0 = MFMA16(fr1[0], Vb[0][0], a0); a1 = MFMA16(fr1[0], Vb[1][0], a1);
              a0 = MFMA16(fr1[1], Vb[0][1], a0); a1 = MFMA16(fr1[1], Vb[1][1], a1);
              S[0][7] = a0; S[1][7] = a1; }
            __builtin_amdgcn_sched_barrier(0);
            }
            BAR_RAW();
#pragma unroll
            for (int n = 0; n < 2; ++n)
#pragma unroll
                for (int mt = 0; mt < 4; ++mt)
#pragma unroll
                    for (int e = 0; e < 4; ++e) ((LAS float*)(L + OT))[(16 * mt + 4 * g + e) * 132 + 32 * wave + 16 * n + r] = o[n][mt][e];
            BAR_RAW();
        }

        {
            const int ch = c2 + 1;
            LAS unsigned char* B0 = L + (ch & 1) * BUF;
            const int cn = (ch + 1 < 64) ? ch + 1 : ch;
#pragma unroll
            for (int n = 0; n < 2; ++n)
#pragma unroll
                for (int mt = 0; mt < 4; ++mt) ua[n][mt] = *(const GAS v2u*)(gu + (size_t)cn * 16384 + (size_t)(((2 * wave + n) * 4 + mt) * 64 + lane) * 8);
            const float eb = __builtin_bit_cast(float, __builtin_amdgcn_readlane(__builtin_bit_cast(int, ebs), ch));
            __builtin_amdgcn_sched_barrier(0);
            bf16x8 Sb[2][4];
#pragma unroll
            for (int n = 0; n < 2; ++n)
#pragma unroll
                for (int kb = 0; kb < 4; ++kb) Sb[n][kb] = pack_b(S[n][2 * kb], S[n][2 * kb + 1]);
            const LAS unsigned char* B0l = B0 + lane * 16;
            bf16x8 fr0[4], fr1[4];
            f32x4 o[2][4], vn[2][4]; bf16x8 Vb[2][2];
#pragma unroll
            for (int n = 0; n < 2; ++n)
#pragma unroll
                for (int mt = 0; mt < 4; ++mt) o[n][mt] = (f32x4){0.f, 0.f, 0.f, 0.f};
            if (!(variant & 2)) {
            fr0[0] = *(const LAS bf16x8*)(B0l + 16384 + 0*1024 + 0*1024); fr0[1] = *(const LAS bf16x8*)(B0l + 16384 + 0*1024 + 1*1024); fr0[2] = *(const LAS bf16x8*)(B0l + 16384 + 0*1024 + 2*1024); fr0[3] = *(const LAS bf16x8*)(B0l + 16384 + 0*1024 + 3*1024);
            fr1[0] = *(const LAS bf16x8*)(B0l + 16384 + 4*1024 + 0*1024); fr1[1] = *(const LAS bf16x8*)(B0l + 16384 + 4*1024 + 1*1024); fr1[2] = *(const LAS bf16x8*)(B0l + 16384 + 4*1024 + 2*1024); fr1[3] = *(const LAS bf16x8*)(B0l + 16384 + 4*1024 + 3*1024);
            __builtin_amdgcn_sched_barrier(0);
            { f32x4 c0 = {0.f, 0.f, 0.f, 0.f}, c1 = {0.f, 0.f, 0.f, 0.f};
              c0 = MFMA16(fr0[0], Sb[0][0], c0); c1 = MFMA16(fr0[0], Sb[1][0], c1);
              c0 = MFMA16(fr0[1], Sb[0][1], c0); c1 = MFMA16(fr0[1], Sb[1][1], c1);
              c0 = MFMA16(fr0[2], Sb[0][2], c0); c1 = MFMA16(fr0[2], Sb[1][2], c1);
              c0 = MFMA16(fr0[3], Sb[0][3], c0); c1 = MFMA16(fr0[3], Sb[1][3], c1);
              o[0][0] = c0; o[1][0] = c1; }
            __builtin_amdgcn_sched_barrier(0);
            fr0[0] = *(const LAS bf16x8*)(B0l + 16384 + 8*1024 + 0*1024); fr0[1] = *(const LAS bf16x8*)(B0l + 16384 + 8*1024 + 1*1024); fr0[2] = *(const LAS bf16x8*)(B0l + 16384 + 8*1024 + 2*1024); fr0[3] = *(const LAS bf16x8*)(B0l + 16384 + 8*1024 + 3*1024);
            __builtin_amdgcn_sched_barrier(0);
            { f32x4 c0 = {0.f, 0.f, 0.f, 0.f}, c1 = {0.f, 0.f, 0.f, 0.f};
              c0 = MFMA16(fr1[0], Sb[0][0], c0); c1 = MFMA16(fr1[0], Sb[1][0], c1);
              c0 = MFMA16(fr1[1], Sb[0][1], c0); c1 = MFMA16(fr1[1], Sb[1][1], c1);
              c0 = MFMA16(fr1[2], Sb[0][2], c0); c1 = MFMA16(fr1[2], Sb[1][2], c1);
              c0 = MFMA16(fr1[3], Sb[0][3], c0); c1 = MFMA16(fr1[3], Sb[1][3], c1);
              o[0][1] = c0; o[1][1] = c1; }
            __builtin_amdgcn_sched_barrier(0);
            fr1[0] = *(const LAS bf16x8*)(B0l + 16384 + 12*1024 + 0*1024); fr1[1] = *(const LAS bf16x8*)(B0l + 16384 + 12*1024 + 1*1024); fr1[2] = *(const LAS bf16x8*)(B0l + 16384 + 12*1024 + 2*1024); fr1[3] = *(const LAS bf16x8*)(B0l + 16384 + 12*1024 + 3*1024);
            __builtin_amdgcn_sched_barrier(0);
            { f32x4 c0 = {0.f, 0.f, 0.f, 0.f}, c1 = {0.f, 0.f, 0.f, 0.f};
              c0 = MFMA16(fr0[0], Sb[0][0], c0); c1 = MFMA16(fr0[0], Sb[1][0], c1);
              c0 = MFMA16(fr0[1], Sb[0][1], c0); c1 = MFMA16(fr0[1], Sb[1][1], c1);
              c0 = MFMA16(fr0[2], Sb[0][2], c0); c1 = MFMA16(fr0[2], Sb[1][2], c1);
              c0 = MFMA16(fr0[3], Sb[0][3], c0); c1 = MFMA16(fr0[3], Sb[1][3], c1);
              o[0][2] = c0; o[1][2] = c1; }
            __builtin_amdgcn_sched_barrier(0);
            fr0[0] = *(const LAS bf16x8*)(B0l + 0*1024 + 0*1024); fr0[1] = *(const LAS bf16x8*)(B0l + 0*1024 + 1*1024); fr0[2] = *(const LAS bf16x8*)(B0l + 0*1024 + 2*1024); fr0[3] = *(const LAS bf16x8*)(B0l + 0*1024 + 3*1024);
            __builtin_amdgcn_sched_barrier(0);
            { f32x4 c0 = {0.f, 0.f, 0.f, 0.f}, c1 = {0.f, 0.f, 0.f, 0.f};
              c0 = MFMA16(fr1[0], Sb[0][0], c0); c1 = MFMA16(fr1[0], Sb[1][0], c1);
              c0 = MFMA16(fr1[1], Sb[0][1], c0); c1 = MFMA16(fr1[1], Sb[1][1], c1);
              c0 = MFMA16(fr1[2], Sb[0][2], c0); c1 = MFMA16(fr1[2], Sb[1][2], c1);
              c0 = MFMA16(fr1[3], Sb[0][3], c0); c1 = MFMA16(fr1[3], Sb[1][3], c1);
              o[0][3] = c0; o[1][3] = c1; }
            __builtin_amdgcn_sched_barrier(0);
            fr1[0] = *(const LAS bf16x8*)(B0l + 4*1024 + 0*1024); fr1[1] = *(const LAS bf16x8*)(B0l + 4*1024 + 1*1024); fr1[2] = *(const LAS bf16x8*)(B0l + 4*1024 + 2*1024); fr1[3] = *(const LAS bf16x8*)(B0l + 4*1024 + 3*1024);
            __builtin_amdgcn_sched_barrier(0);
            { f32x4 a0 = {0.f, 0.f, 0.f, 0.f}, a1 = {0.f, 0.f, 0.f, 0.f};
              a0 = MFMA16(fr0[0], Sb[0][0], a0); a1 = MFMA16(fr0[0], Sb[1][0], a1);
              a0 = MFMA16(fr0[1], Sb[0][1], a0); a1 = MFMA16(fr0[1], Sb[1][1], a1);
              a0 = MFMA16(fr0[2], Sb[0][2], a0); a1 = MFMA16(fr0[2], Sb[1][2], a1);
              a0 = MFMA16(fr0[3], Sb[0][3], a0); a1 = MFMA16(fr0[3], Sb[1][3], a1);
              vn[0][0] = (f32x4){bflo(ub[0][0].x), bfhi(ub[0][0].x), bflo(ub[0][0].y), bfhi(ub[0][0].y)} - a0; vn[1][0] = (f32x4){bflo(ub[1][0].x), bfhi(ub[1][0].x), bflo(ub[1][0].y), bfhi(ub[1][0].y)} - a1; }
            __builtin_amdgcn_sched_barrier(0);
            fr0[0] = *(const LAS bf16x8*)(B0l + 8*1024 + 0*1024); fr0[1] = *(const LAS bf16x8*)(B0l + 8*1024 + 1*1024); fr0[2] = *(const LAS bf16x8*)(B0l + 8*1024 + 2*1024); fr0[3] = *(const LAS bf16x8*)(B0l + 8*1024 + 3*1024);
            __builtin_amdgcn_sched_barrier(0);
            { f32x4 a0 = {0.f, 0.f, 0.f, 0.f}, a1 = {0.f, 0.f, 0.f, 0.f};
              a0 = MFMA16(fr1[0], Sb[0][0], a0); a1 = MFMA16(fr1[0], Sb[1][0], a1);
              a0 = MFMA16(fr1[1], Sb[0][1], a0); a1 = MFMA16(fr1[1], Sb[1][1], a1);
              a0 = MFMA16(fr1[2], Sb[0][2], a0); a1 = MFMA16(fr1[2], Sb[1][2], a1);
              a0 = MFMA16(fr1[3], Sb[0][3], a0); a1 = MFMA16(fr1[3], Sb[1][3], a1);
              vn[0][1] = (f32x4){bflo(ub[0][1].x), bfhi(ub[0][1].x), bflo(ub[0][1].y), bfhi(ub[0][1].y)} - a0; vn[1][1] = (f32x4){bflo(ub[1][1].x), bfhi(ub[1][1].x), bflo(ub[1][1].y), bfhi(ub[1][1].y)} - a1; }
            __builtin_amdgcn_sched_barrier(0);
            fr1[0] = *(const LAS bf16x8*)(B0l + 12*1024 + 0*1024); fr1[1] = *(const LAS bf16x8*)(B0l + 12*1024 + 1*1024); fr1[2] = *(const LAS bf16x8*)(B0l + 12*1024 + 2*1024); fr1[3] = *(const LAS bf16x8*)(B0l + 12*1024 + 3*1024);
            __builtin_amdgcn_sched_barrier(0);
            { f32x4 a0 = {0.f, 0.f, 0.f, 0.f}, a1 = {0.f, 0.f, 0.f, 0.f};
              a0 = MFMA16(fr0[0], Sb[0][0], a0); a1 = MFMA16(fr0[0], Sb[1][0], a1);
              a0 = MFMA16(fr0[1], Sb[0][1], a0); a1 = MFMA16(fr0[1], Sb[1][1], a1);
              a0 = MFMA16(fr0[2], Sb[0][2], a0); a1 = MFMA16(fr0[2], Sb[1][2], a1);
              a0 = MFMA16(fr0[3], Sb[0][3], a0); a1 = MFMA16(fr0[3], Sb[1][3], a1);
              vn[0][2] = (f32x4){bflo(ub[0][2].x), bfhi(ub[0][2].x), bflo(ub[0][2].y), bfhi(ub[0][2].y)} - a0; vn[1][2] = (f32x4){bflo(ub[1][2].x), bfhi(ub[1][2].x), bflo(ub[1][2].y), bfhi(ub[1][2].y)} - a1; }
            __builtin_amdgcn_sched_barrier(0);
            fr0[0] = *(const LAS bf16x8*)(B0l + 49152 + 0*1024 + 0*1024); fr0[1] = *(const LAS bf16x8*)(B0l + 49152 + 0*1024 + 1*1024);
            __builtin_amdgcn_sched_barrier(0);
            { f32x4 a0 = {0.f, 0.f, 0.f, 0.f}, a1 = {0.f, 0.f, 0.f, 0.f};
              a0 = MFMA16(fr1[0], Sb[0][0], a0); a1 = MFMA16(fr1[0], Sb[1][0], a1);
              a0 = MFMA16(fr1[1], Sb[0][1], a0); a1 = MFMA16(fr1[1], Sb[1][1], a1);
              a0 = MFMA16(fr1[2], Sb[0][2], a0); a1 = MFMA16(fr1[2], Sb[1][2], a1);
              a0 = MFMA16(fr1[3], Sb[0][3], a0); a1 = MFMA16(fr1[3], Sb[1][3], a1);
              vn[0][3] = (f32x4){bflo(ub[0][3].x), bfhi(ub[0][3].x), bflo(ub[0][3].y), bfhi(ub[0][3].y)} - a0; vn[1][3] = (f32x4){bflo(ub[1][3].x), bfhi(ub[1][3].x), bflo(ub[1][3].y), bfhi(ub[1][3].y)} - a1; }
            Vb[0][0] = pack_b(vn[0][0], vn[0][1]); Vb[0][1] = pack_b(vn[0][2], vn[0][3]); Vb[1][0] = pack_b(vn[1][0], vn[1][1]); Vb[1][1] = pack_b(vn[1][2], vn[1][3]);
            __builtin_amdgcn_sched_barrier(0);
            fr1[0] = *(const LAS bf16x8*)(B0l + 49152 + 2*1024 + 0*1024); fr1[1] = *(const LAS bf16x8*)(B0l + 49152 + 2*1024 + 1*1024);
            __builtin_amdgcn_sched_barrier(0);
            o[0][0] = MFMA16(fr0[0], Vb[0][0], o[0][0]); o[1][0] = MFMA16(fr0[0], Vb[1][0], o[1][0]);
            o[0][0] = MFMA16(fr0[1], Vb[0][1], o[0][0]); o[1][0] = MFMA16(fr0[1], Vb[1][1], o[1][0]);
            __builtin_amdgcn_sched_barrier(0);
            fr0[0] = *(const LAS bf16x8*)(B0l + 49152 + 4*1024 + 0*1024); fr0[1] = *(const LAS bf16x8*)(B0l + 49152 + 4*1024 + 1*1024);
            __builtin_amdgcn_sched_barrier(0);
            o[0][1] = MFMA16(fr1[0], Vb[0][0], o[0][1]); o[1][1] = MFMA16(fr1[0], Vb[1][0], o[1][1]);
            o[0][1] = MFMA16(fr1[1], Vb[0][1], o[0][1]); o[1][1] = MFMA16(fr1[1], Vb[1][1], o[1][1]);
            __builtin_amdgcn_sched_barrier(0);
            fr1[0] = *(const LAS bf16x8*)(B0l + 49152 + 6*1024 + 0*1024); fr1[1] = *(const LAS bf16x8*)(B0l + 49152 + 6*1024 + 1*1024);
            __builtin_amdgcn_sched_barrier(0);
            o[0][2] = MFMA16(fr0[0], Vb[0][0], o[0][2]); o[1][2] = MFMA16(fr0[0], Vb[1][0], o[1][2]);
            o[0][2] = MFMA16(fr0[1], Vb[0][1], o[0][2]); o[1][2] = MFMA16(fr0[1], Vb[1][1], o[1][2]);
            __builtin_amdgcn_sched_barrier(0);
            fr0[0] = *(const LAS bf16x8*)(B0l + 32768 + 0*1024 + 0*1024); fr0[1] = *(const LAS bf16x8*)(B0l + 32768 + 0*1024 + 1*1024);
            __builtin_amdgcn_sched_barrier(0);
            o[0][3] = MFMA16(fr1[0], Vb[0][0], o[0][3]); o[1][3] = MFMA16(fr1[0], Vb[1][0], o[1][3]);
            o[0][3] = MFMA16(fr1[1], Vb[0][1], o[0][3]); o[1][3] = MFMA16(fr1[1], Vb[1][1], o[1][3]);
            __builtin_amdgcn_sched_barrier(0);
            fr1[0] = *(const LAS bf16x8*)(B0l + 32768 + 2*1024 + 0*1024); fr1[1] = *(const LAS bf16x8*)(B0l + 32768 + 2*1024 + 1*1024);
            __builtin_amdgcn_sched_barrier(0);
            { f32x4 a0 = S[0][0] * eb, a1 = S[1][0] * eb;
              a0 = MFMA16(fr0[0], Vb[0][0], a0); a1 = MFMA16(fr0[0], Vb[1][0], a1);
              a0 = MFMA16(fr0[1], Vb[0][1], a0); a1 = MFMA16(fr0[1], Vb[1][1], a1);
              S[0][0] = a0; S[1][0] = a1; }
            __builtin_amdgcn_sched_barrier(0);
            fr0[0] = *(const LAS bf16x8*)(B0l + 32768 + 4*1024 + 0*1024); fr0[1] = *(const LAS bf16x8*)(B0l + 32768 + 4*1024 + 1*1024);
            __builtin_amdgcn_sched_barrier(0);
            { f32x4 a0 = S[0][1] * eb, a1 = S[1][1] * eb;
              a0 = MFMA16(fr1[0], Vb[0][0], a0); a1 = MFMA16(fr1[0], Vb[1][0], a1);
              a0 = MFMA16(fr1[1], Vb[0][1], a0); a1 = MFMA16(fr1[1], Vb[1][1], a1);
              S[0][1] = a0; S[1][1] = a1; }
            __builtin_amdgcn_sched_barrier(0);
            fr1[0] = *(const LAS bf16x8*)(B0l + 32768 + 6*1024 + 0*1024); fr1[1] = *(const LAS bf16x8*)(B0l + 32768 + 6*1024 + 1*1024);
            __builtin_amdgcn_sched_barrier(0);
            { f32x4 a0 = S[0][2] * eb, a1 = S[1][2] * eb;
              a0 = MFMA16(fr0[0], Vb[0][0], a0); a1 = MFMA16(fr0[0], Vb[1][0], a1);
              a0 = MFMA16(fr0[1], Vb[0][1], a0); a1 = MFMA16(fr0[1], Vb[1][1], a1);
              S[0][2] = a0; S[1][2] = a1; }
            __builtin_amdgcn_sched_barrier(0);
            fr0[0] = *(const LAS bf16x8*)(B0l + 32768 + 8*1024 + 0*1024); fr0[1] = *(const LAS bf16x8*)(B0l + 32768 + 8*1024 + 1*1024);
            __builtin_amdgcn_sched_barrier(0);
            { f32x4 a0 = S[0][3] * eb, a1 = S[1][3] * eb;
              a0 = MFMA16(fr1[0], Vb[0][0], a0); a1 = MFMA16(fr1[0], Vb[1][0], a1);
              a0 = MFMA16(fr1[1], Vb[0][1], a0); a1 = MFMA16(fr1[1], Vb[1][1], a1);
              S[0][3] = a0; S[1][3] = a1; }
            __builtin_amdgcn_sched_barrier(0);
            fr1[0] = *(const LAS bf16x8*)(B0l + 32768 + 10*1024 + 0*1024); fr1[1] = *(const LAS bf16x8*)(B0l + 32768 + 10*1024 + 1*1024);
            __builtin_amdgcn_sched_barrier(0);
            { f32x4 a0 = S[0][4] * eb, a1 = S[1][4] * eb;
              a0 = MFMA16(fr0[0], Vb[0][0], a0); a1 = MFMA16(fr0[0], Vb[1][0], a1);
              a0 = MFMA16(fr0[1], Vb[0][1], a0); a1 = MFMA16(fr0[1], Vb[1][1], a1);
              S[0][4] = a0; S[1][4] = a1; }
            __builtin_amdgcn_sched_barrier(0);
            fr0[0] = *(const LAS bf16x8*)(B0l + 32768 + 12*1024 + 0*1024); fr0[1] = *(const LAS bf16x8*)(B0l + 32768 + 12*1024 + 1*1024);
            __builtin_amdgcn_sched_barrier(0);
            { f32x4 a0 = S[0][5] * eb, a1 = S[1][5] * eb;
              a0 = MFMA16(fr1[0], Vb[0][0], a0); a1 = MFMA16(fr1[0], Vb[1][0], a1);
              a0 = MFMA16(fr1[1], Vb[0][1], a0); a1 = MFMA16(fr1[1], Vb[1][1], a1);
              S[0][5] = a0; S[1][5] = a1; }
            __builtin_amdgcn_sched_barrier(0);
            fr1[0] = *(const LAS bf16x8*)(B0l + 32768 + 14*1024 + 0*1024); fr1[1] = *(const LAS bf16x8*)(B0l + 32768 + 14*1024 + 1*1024);
            __builtin_amdgcn_sched_barrier(0);
            { f32x4 a0 = S[0][6] * eb, a1 = S[1][6] * eb;
              a0 = MFMA16(fr0[0], Vb[0][0], a0); a1 = MFMA16(fr0[0], Vb[1][0], a1);
              a0 = MFMA16(fr0[1], Vb[0][1], a0); a1 = MFMA16(fr0[1], Vb[1][1], a1);
              S[0][6] = a0; S[1][6] = a1; }
            __builtin_amdgcn_sched_barrier(0);
            __builtin_amdgcn_sched_barrier(0);
            { f32x4 a0 = S[0][7] * eb, a1 = S[1][7] * eb;
              a0 = MFMA16(fr1[0], Vb[0][0], a0); a1 = MFMA16(fr1[0], Vb[1][0], a1);
              a0 = MFMA16(fr1[1], Vb[0][1], a0); a1 = MFMA16(fr1[1], Vb[1][1], a1);
              S[0][7] = a0; S[1][7] = a1; }
            __builtin_amdgcn_sched_barrier(0);
            }
            BAR_RAW();
#pragma unroll
            for (int n = 0; n < 2; ++n)
#pragma unroll
                for (int mt = 0; mt < 4; ++mt)
#pragma unroll
                    for (int e = 0; e < 4; ++e) ((LAS float*)(L + OT))[(16 * mt + 4 * g + e) * 132 + 32 * wave + 16 * n + r] = o[n][mt][e];
            BAR_RAW();
        }

        }
        BAR_RAW(); BAR_RAW();
    } else {
        if (wave < 6) {
            const int l16 = lane * 16, w2 = 2 * (wave - 4);
#define GDN_DMA(CK) do { const int ck_ = (CK); LAS unsigned char* Bd_ = L + (ck_ & 1) * BUF + w2 * 1024; const size_t o16_ = (size_t)ck_ * 16384 + w2 * 1024 + l16, o8_ = (size_t)ck_ * 8192 + w2 * 1024 + l16; \
            _Pragma("unroll") for (int k = 0; k < 4; ++k) _Pragma("unroll") for (int i = 0; i < 2; ++i) { \
                __builtin_amdgcn_global_load_lds((const unsigned*)(gw + o16_ + k * 4096 + i * 1024), (LAS unsigned*)(Bd_ + k * 4096 + i * 1024), 16, 0, 0); \
                __builtin_amdgcn_global_load_lds((const unsigned*)(gq + o16_ + k * 4096 + i * 1024), (LAS unsigned*)(Bd_ + 16384 + k * 4096 + i * 1024), 16, 0, 0); \
                __builtin_amdgcn_global_load_lds((const unsigned*)(gk + o16_ + k * 4096 + i * 1024), (LAS unsigned*)(Bd_ + 32768 + k * 4096 + i * 1024), 16, 0, 0); } \
            _Pragma("unroll") for (int k = 0; k < 2; ++k) _Pragma("unroll") for (int i = 0; i < 2; ++i) \
                __builtin_amdgcn_global_load_lds((const unsigned*)(ga + o8_ + k * 4096 + i * 1024), (LAS unsigned*)(Bd_ + 49152 + k * 4096 + i * 1024), 16, 0, 0); } while (0)
            GDN_DMA(1);
#pragma unroll 1
            for (int ch = 0; ch < 65; ++ch) {
                BAR_RAW();
                asm volatile("s_waitcnt vmcnt(0)" ::: "memory");
                BAR_RAW();
                if (ch + 2 < 64) GDN_DMA(ch + 2);
            }
#undef GDN_DMA
        } else {
            const int hn = tid - 384, nt_t = hn >> 1, nt_c0 = 64 * (hn & 1);
            bf16* MIX = (bf16*)(F.ws + WS_MIX);
            const bf16* zbase = (const bf16*)(F.ws + WS_GZ) + ((size_t)bh * SEQ + nt_t) * 128 + nt_c0;
            v4u za[8], zb[8];
#pragma unroll
            for (int i = 0; i < 8; ++i) { za[i] = (v4u){0u, 0u, 0u, 0u}; zb[i] = (v4u){0u, 0u, 0u, 0u}; }
#pragma unroll 1
            for (int c2 = 0; c2 < 66; c2 += 2) {
            {
                const int ch = c2;
                const int cz = (ch < 64) ? ch : 63;
#pragma unroll
                for (int i = 0; i < 8; ++i) zb[i] = *(const GAS v4u*)(zbase + (size_t)cz * 64 * 128 + 8 * i);
                __builtin_amdgcn_sched_barrier(0);
                if (ch > 0 && !(variant & 1)) {
                    const size_t m = (size_t)b * SEQ + (ch - 1) * 64 + nt_t;
                    const LAS float* op = (const LAS float*)(L + OT) + nt_t * 132 + nt_c0;
                    f32x4 x[16]; float ss = 0.f;
#pragma unroll
                    for (int q4 = 0; q4 < 16; ++q4) { x[q4] = *(const LAS f32x4*)(op + 4 * q4); ss += (x[q4].x * x[q4].x + x[q4].y * x[q4].y) + (x[q4].z * x[q4].z + x[q4].w * x[q4].w); }
                    ss += __shfl_xor(ss, 1);
                    const float rs = frsq(ss * (1.f / 128.f) + EPS);
                    bf16* mp = MIX + m * D + MIX_C + h * 128 + nt_c0;
#pragma unroll
                    for (int i = 0; i < 8; ++i) {
                        const f32x4 xa = x[2 * i] * rs, xb = x[2 * i + 1] * rs;
                        v4u w;
                        w.x = pk2(xa.x * bflo(za[i].x), xa.y * bfhi(za[i].x)); w.y = pk2(xa.z * bflo(za[i].y), xa.w * bfhi(za[i].y));
                        w.z = pk2(xb.x * bflo(za[i].z), xb.y * bfhi(za[i].z)); w.w = pk2(xb.z * bflo(za[i].w), xb.w * bfhi(za[i].w));
                        *(GAS v4u*)(mp + 8 * i) = w;
                    }
                }
                BAR_RAW();
                BAR_RAW();
            }

                if (c2 + 1 > 64) break;
            {
                const int ch = c2 + 1;
                const int cz = (ch < 64) ? ch : 63;
#pragma unroll
                for (int i = 0; i < 8; ++i) za[i] = *(const GAS v4u*)(zbase + (size_t)cz * 64 * 128 + 8 * i);
                __builtin_amdgcn_sched_barrier(0);
                if (ch > 0 && !(variant & 1)) {
                    const size_t m = (size_t)b * SEQ + (ch - 1) * 64 + nt_t;
                    const LAS float* op = (const LAS float*)(L + OT) + nt_t * 132 + nt_c0;
                    f32x4 x[16]; float ss = 0.f;
#pragma unroll
                    for (int q4 = 0; q4 < 16; ++q4) { x[q4] = *(const LAS f32x4*)(op + 4 * q4); ss += (x[q4].x * x[q4].x + x[q4].y * x[q4].y) + (x[q4].z * x[q4].z + x[q4].w * x[q4].w); }
                    ss += __shfl_xor(ss, 1);
                    const float rs = frsq(ss * (1.f / 128.f) + EPS);
                    bf16* mp = MIX + m * D + MIX_C + h * 128 + nt_c0;
#pragma unroll
                    for (int i = 0; i < 8; ++i) {
                        const f32x4 xa = x[2 * i] * rs, xb = x[2 * i + 1] * rs;
                        v4u w;
                        w.x = pk2(xa.x * bflo(zb[i].x), xa.y * bfhi(zb[i].x)); w.y = pk2(xa.z * bflo(zb[i].y), xa.w * bfhi(zb[i].y));
                        w.z = pk2(xb.x * bflo(zb[i].z), xb.y * bfhi(zb[i].z)); w.w = pk2(xb.z * bflo(zb[i].w), xb.w * bfhi(zb[i].w));
                        *(GAS v4u*)(mp + 8 * i) = w;
                    }
                }
                BAR_RAW();
                BAR_RAW();
            }

            }
        }
    }
}

DI void hgrn_scan(const Frame& F, int bh, int layer) {
    const int b = bh / 6, h = bh % 6, tid = F.tid, lane = F.lane, wave = F.wave, r = lane & 15, g = lane >> 4;
    LAS unsigned char* L = F.lds;
    constexpr int BUF = 18944, VB = 56832, OT = 81408;
    const unsigned char* hq = F.ws + WS_HQ + (size_t)bh * 128 * 8192; const unsigned char* hk = F.ws + WS_HK + (size_t)bh * 128 * 8192;
    const unsigned char* hv = F.ws + WS_HV + (size_t)bh * 128 * 8192; const unsigned char* ha = F.ws + WS_HA + (size_t)bh * 128 * 2048;
    const unsigned char* he = F.ws + WS_HE + (size_t)bh * 128 * 512;
    copy_g2l(L, hq, 8192, tid); copy_g2l(L + 8192, hk, 8192, tid); copy_g2l(L + 16384, ha, 2048, tid); copy_g2l(L + 18432, he, 512, tid); copy_g2l(L + VB, hv, 8192, tid);
    BAR_RAW();
    if (wave < 4) {
        f32x4 S[2][8];
#pragma unroll
        for (int n = 0; n < 2; ++n)
#pragma unroll
            for (int i = 0; i < 8; ++i) S[n][i] = (f32x4){0.f, 0.f, 0.f, 0.f};
        const int l16 = lane * 16;
#define HG_DMA(CK, BJ) do { const int ck_ = (CK); LAS unsigned char* Bd_ = L + (BJ) * BUF; LAS unsigned char* Vd_ = L + VB + (BJ) * 8192; const size_t o8_ = (size_t)ck_ * 8192 + (2 * wave) * 1024 + l16; \
        _Pragma("unroll") for (int i = 0; i < 2; ++i) { \
            __builtin_amdgcn_global_load_lds((const unsigned*)(hq + o8_ + i * 1024), (LAS unsigned*)(Bd_ + (2 * wave + i) * 1024), 16, 0, 0); \
            __builtin_amdgcn_global_load_lds((const unsigned*)(hk + o8_ + i * 1024), (LAS unsigned*)(Bd_ + 8192 + (2 * wave + i) * 1024), 16, 0, 0); \
            __builtin_amdgcn_global_load_lds((const unsigned*)(hv + o8_ + i * 1024), (LAS unsigned*)(Vd_ + (2 * wave + i) * 1024), 16, 0, 0); } \
        if (wave < 2) __builtin_amdgcn_global_load_lds((const unsigned*)(ha + (size_t)ck_ * 2048 + wave * 1024 + l16), (LAS unsigned*)(Bd_ + 16384 + wave * 1024), 16, 0, 0); \
        if (wave == 2 && lane < 32) __builtin_amdgcn_global_load_lds((const unsigned*)(he + (size_t)ck_ * 512 + l16), (LAS unsigned*)(Bd_ + 18432), 16, 0, 0); } while (0)
        HG_DMA(1, 1); HG_DMA(2, 2);
#pragma unroll 1
        for (int c3 = 0; c3 < 128; c3 += 3) {
        {
            const int ch = c3 + 0;
            LAS unsigned char* B0 = L + 0 * BUF;
            bf16x8 va[2];
            va[0] = *(const LAS bf16x8*)(L + VB + 0 * 8192 + (size_t)((2 * wave + 0) * 64 + lane) * 16); va[1] = *(const LAS bf16x8*)(L + VB + 0 * 8192 + (size_t)((2 * wave + 1) * 64 + lane) * 16);
            __builtin_amdgcn_sched_barrier(0);
            bf16x8 Sb[2][4];
#pragma unroll
            for (int n = 0; n < 2; ++n)
#pragma unroll
                for (int kb = 0; kb < 4; ++kb) Sb[n][kb] = pack_b(S[n][2 * kb], S[n][2 * kb + 1]);
            const LAS unsigned char* B0l = B0 + lane * 16;
            bf16x8 fq0[5], fq1[5]; f32x4 o[2][2];
            bf16x8 fk0[2], fk1[2]; f32x4 fe0[2], fe1[2];
            fq0[0] = *(const LAS bf16x8*)(B0l + 0*1024); fq0[1] = *(const LAS bf16x8*)(B0l + 1*1024); fq0[2] = *(const LAS bf16x8*)(B0l + 2*1024); fq0[3] = *(const LAS bf16x8*)(B0l + 3*1024); fq0[4] = *(const LAS bf16x8*)(B0l + 16384 + 0*1024);
            fq1[0] = *(const LAS bf16x8*)(B0l + 4*1024); fq1[1] = *(const LAS bf16x8*)(B0l + 5*1024); fq1[2] = *(const LAS bf16x8*)(B0l + 6*1024); fq1[3] = *(const LAS bf16x8*)(B0l + 7*1024); fq1[4] = *(const LAS bf16x8*)(B0l + 16384 + 1*1024);
            __builtin_amdgcn_sched_barrier(0);
            { f32x4 c0 = {0.f, 0.f, 0.f, 0.f}, c1 = {0.f, 0.f, 0.f, 0.f};
              c0 = MFMA16(fq0[0], Sb[0][0], c0); c1 = MFMA16(fq0[0], Sb[1][0], c1);
              c0 = MFMA16(fq0[1], Sb[0][1], c0); c1 = MFMA16(fq0[1], Sb[1][1], c1);
              c0 = MFMA16(fq0[2], Sb[0][2], c0); c1 = MFMA16(fq0[2], Sb[1][2], c1);
              c0 = MFMA16(fq0[3], Sb[0][3], c0); c1 = MFMA16(fq0[3], Sb[1][3], c1);
              o[0][0] = MFMA16(fq0[4], va[0], c0); o[1][0] = MFMA16(fq0[4], va[1], c1); }
            fk0[0] = *(const LAS bf16x8*)(B0l + 8192 + 0*1024); fe0[0] = *(const LAS f32x4*)(B0 + 18432 + (16 * 0 + 4 * g) * 4); fk0[1] = *(const LAS bf16x8*)(B0l + 8192 + 1*1024); fe0[1] = *(const LAS f32x4*)(B0 + 18432 + (16 * 1 + 4 * g) * 4);
            __builtin_amdgcn_sched_barrier(0);
            { f32x4 c0 = {0.f, 0.f, 0.f, 0.f}, c1 = {0.f, 0.f, 0.f, 0.f};
              c0 = MFMA16(fq1[0], Sb[0][0], c0); c1 = MFMA16(fq1[0], Sb[1][0], c1);
              c0 = MFMA16(fq1[1], Sb[0][1], c0); c1 = MFMA16(fq1[1], Sb[1][1], c1);
              c0 = MFMA16(fq1[2], Sb[0][2], c0); c1 = MFMA16(fq1[2], Sb[1][2], c1);
              c0 = MFMA16(fq1[3], Sb[0][3], c0); c1 = MFMA16(fq1[3], Sb[1][3], c1);
              o[0][1] = MFMA16(fq1[4], va[0], c0); o[1][1] = MFMA16(fq1[4], va[1], c1); }
            fk1[0] = *(const LAS bf16x8*)(B0l + 8192 + 2*1024); fe1[0] = *(const LAS f32x4*)(B0 + 18432 + (16 * 2 + 4 * g) * 4); fk1[1] = *(const LAS bf16x8*)(B0l + 8192 + 3*1024); fe1[1] = *(const LAS f32x4*)(B0 + 18432 + (16 * 3 + 4 * g) * 4);
            __builtin_amdgcn_sched_barrier(0);
            S[0][0] = MFMA16(fk0[0], va[0], S[0][0] * fe0[0]); S[1][0] = MFMA16(fk0[0], va[1], S[1][0] * fe0[0]);
            S[0][1] = MFMA16(fk0[1], va[0], S[0][1] * fe0[1]); S[1][1] = MFMA16(fk0[1], va[1], S[1][1] * fe0[1]);
            __builtin_amdgcn_sched_barrier(0);
            fk0[0] = *(const LAS bf16x8*)(B0l + 8192 + 4*1024); fe0[0] = *(const LAS f32x4*)(B0 + 18432 + (16 * 4 + 4 * g) * 4); fk0[1] = *(const LAS bf16x8*)(B0l + 8192 + 5*1024); fe0[1] = *(const LAS f32x4*)(B0 + 18432 + (16 * 5 + 4 * g) * 4);
            __builtin_amdgcn_sched_barrier(0);
            S[0][2] = MFMA16(fk1[0], va[0], S[0][2] * fe1[0]); S[1][2] = MFMA16(fk1[0], va[1], S[1][2] * fe1[0]);
            S[0][3] = MFMA16(fk1[1], va[0], S[0][3] * fe1[1]); S[1][3] = MFMA16(fk1[1], va[1], S[1][3] * fe1[1]);
            __builtin_amdgcn_sched_barrier(0);
            fk1[0] = *(const LAS bf16x8*)(B0l + 8192 + 6*1024); fe1[0] = *(const LAS f32x4*)(B0 + 18432 + (16 * 6 + 4 * g) * 4); fk1[1] = *(const LAS bf16x8*)(B0l + 8192 + 7*1024); fe1[1] = *(const LAS f32x4*)(B0 + 18432 + (16 * 7 + 4 * g) * 4);
            __builtin_amdgcn_sched_barrier(0);
            S[0][4] = MFMA16(fk0[0], va[0], S[0][4] * fe0[0]); S[1][4] = MFMA16(fk0[0], va[1], S[1][4] * fe0[0]);
            S[0][5] = MFMA16(fk0[1], va[0], S[0][5] * fe0[1]); S[1][5] = MFMA16(fk0[1], va[1], S[1][5] * fe0[1]);
            __builtin_amdgcn_sched_barrier(0);
            __builtin_amdgcn_sched_barrier(0);
            S[0][6] = MFMA16(fk1[0], va[0], S[0][6] * fe1[0]); S[1][6] = MFMA16(fk1[0], va[1], S[1][6] * fe1[0]);
            S[0][7] = MFMA16(fk1[1], va[0], S[0][7] * fe1[1]); S[1][7] = MFMA16(fk1[1], va[1], S[1][7] * fe1[1]);
            __builtin_amdgcn_sched_barrier(0);
            BAR_RAW();
#pragma unroll
            for (int n = 0; n < 2; ++n)
#pragma unroll
                for (int mt = 0; mt < 2; ++mt)
#pragma unroll
                    for (int e = 0; e < 4; ++e) ((LAS float*)(L + OT))[(16 * mt + 4 * g + e) * 132 + 32 * wave + 16 * n + r] = o[n][mt][e];
            if (ch + 2 < 128) { if (wave < 3) asm volatile("s_waitcnt vmcnt(7)" ::: "memory"); else asm volatile("s_waitcnt vmcnt(6)" ::: "memory"); }
            else asm volatile("s_waitcnt vmcnt(0)" ::: "memory");
            BAR_RAW();
            if (ch + 3 < 128) HG_DMA(ch + 3, 0);
        }

            if (c3 + 1 >= 128) break;
        {
            const int ch = c3 + 1;
            LAS unsigned char* B0 = L + 1 * BUF;
            bf16x8 va[2];
            va[0] = *(const LAS bf16x8*)(L + VB + 1 * 8192 + (size_t)((2 * wave + 0) * 64 + lane) * 16); va[1] = *(const LAS bf16x8*)(L + VB + 1 * 8192 + (size_t)((2 * wave + 1) * 64 + lane) * 16);
            __builtin_amdgcn_sched_barrier(0);
            bf16x8 Sb[2][4];
#pragma unroll
            for (int n = 0; n < 2; ++n)
#pragma unroll
                for (int kb = 0; kb < 4; ++kb) Sb[n][kb] = pack_b(S[n][2 * kb], S[n][2 * kb + 1]);
            const LAS unsigned char* B0l = B0 + lane * 16;
            bf16x8 fq0[5], fq1[5]; f32x4 o[2][2];
            bf16x8 fk0[2], fk1[2]; f32x4 fe0[2], fe1[2];
            fq0[0] = *(const LAS bf16x8*)(B0l + 0*1024); fq0[1] = *(const LAS bf16x8*)(B0l + 1*1024); fq0[2] = *(const LAS bf16x8*)(B0l + 2*1024); fq0[3] = *(const LAS bf16x8*)(B0l + 3*1024); fq0[4] = *(const LAS bf16x8*)(B0l + 16384 + 0*1024);
            fq1[0] = *(const LAS bf16x8*)(B0l + 4*1024); fq1[1] = *(const LAS bf16x8*)(B0l + 5*1024); fq1[2] = *(const LAS bf16x8*)(B0l + 6*1024); fq1[3] = *(const LAS bf16x8*)(B0l + 7*1024); fq1[4] = *(const LAS bf16x8*)(B0l + 16384 + 1*1024);
            __builtin_amdgcn_sched_barrier(0);
            { f32x4 c0 = {0.f, 0.f, 0.f, 0.f}, c1 = {0.f, 0.f, 0.f, 0.f};
              c0 = MFMA16(fq0[0], Sb[0][0], c0); c1 = MFMA16(fq0[0], Sb[1][0], c1);
              c0 = MFMA16(fq0[1], Sb[0][1], c0); c1 = MFMA16(fq0[1], Sb[1][1], c1);
              c0 = MFMA16(fq0[2], Sb[0][2], c0); c1 = MFMA16(fq0[2], Sb[1][2], c1);
              c0 = MFMA16(fq0[3], Sb[0][3], c0); c1 = MFMA16(fq0[3], Sb[1][3], c1);
              o[0][0] = MFMA16(fq0[4], va[0], c0); o[1][0] = MFMA16(fq0[4], va[1], c1); }
            fk0[0] = *(const LAS bf16x8*)(B0l + 8192 + 0*1024); fe0[0] = *(const LAS f32x4*)(B0 + 18432 + (16 * 0 + 4 * g) * 4); fk0[1] = *(const LAS bf16x8*)(B0l + 8192 + 1*1024); fe0[1] = *(const LAS f32x4*)(B0 + 18432 + (16 * 1 + 4 * g) * 4);
            __builtin_amdgcn_sched_barrier(0);
            { f32x4 c0 = {0.f, 0.f, 0.f, 0.f}, c1 = {0.f, 0.f, 0.f, 0.f};
              c0 = MFMA16(fq1[0], Sb[0][0], c0); c1 = MFMA16(fq1[0], Sb[1][0], c1);
              c0 = MFMA16(fq1[1], Sb[0][1], c0); c1 = MFMA16(fq1[1], Sb[1][1], c1);
              c0 = MFMA16(fq1[2], Sb[0][2], c0); c1 = MFMA16(fq1[2], Sb[1][2], c1);
              c0 = MFMA16(fq1[3], Sb[0][3], c0); c1 = MFMA16(fq1[3], Sb[1][3], c1);
              o[0][1] = MFMA16(fq1[4], va[0], c0); o[1][1] = MFMA16(fq1[4], va[1], c1); }
            fk1[0] = *(const LAS bf16x8*)(B0l + 8192 + 2*1024); fe1[0] = *(const LAS f32x4*)(B0 + 18432 + (16 * 2 + 4 * g) * 4); fk1[1] = *(const LAS bf16x8*)(B0l + 8192 + 3*1024); fe1[1] = *(const LAS f32x4*)(B0 + 18432 + (16 * 3 + 4 * g) * 4);
            __builtin_amdgcn_sched_barrier(0);
            S[0][0] = MFMA16(fk0[0], va[0], S[0][0] * fe0[0]); S[1][0] = MFMA16(fk0[0], va[1], S[1][0] * fe0[0]);
            S[0][1] = MFMA16(fk0[1], va[0], S[0][1] * fe0[1]); S[1][1] = MFMA16(fk0[1], va[1], S[1][1] * fe0[1]);
            __builtin_amdgcn_sched_barrier(0);
            fk0[0] = *(const LAS bf16x8*)(B0l + 8192 + 4*1024); fe0[0] = *(const LAS f32x4*)(B0 + 18432 + (16 * 4 + 4 * g) * 4); fk0[1] = *(const LAS bf16x8*)(B0l + 8192 + 5*1024); fe0[1] = *(const LAS f32x4*)(B0 + 18432 + (16 * 5 + 4 * g) * 4);
            __builtin_amdgcn_sched_barrier(0);
            S[0][2] = MFMA16(fk1[0], va[0], S[0][2] * fe1[0]); S[1][2] = MFMA16(fk1[0], va[1], S[1][2] * fe1[0]);
            S[0][3] = MFMA16(fk1[1], va[0], S[0][3] * fe1[1]); S[1][3] = MFMA16(fk1[1], va[1], S[1][3] * fe1[1]);
            __builtin_amdgcn_sched_barrier(0);
            fk1[0] = *(const LAS bf16x8*)(B0l + 8192 + 6*1024); fe1[0] = *(const LAS f32x4*)(B0 + 18432 + (16 * 6 + 4 * g) * 4); fk1[1] = *(const LAS bf16x8*)(B0l + 8192 + 7*1024); fe1[1] = *(const LAS f32x4*)(B0 + 18432 + (16 * 7 + 4 * g) * 4);
            __builtin_amdgcn_sched_barrier(0);
            S[0][4] = MFMA16(fk0[0], va[0], S[0][4] * fe0[0]); S[1][4] = MFMA16(fk0[0], va[1], S[1][4] * fe0[0]);
            S[0][5] = MFMA16(fk0[1], va[0], S[0][5] * fe0[1]); S[1][5] = MFMA16(fk0[1], va[1], S[1][5] * fe0[1]);
            __builtin_amdgcn_sched_barrier(0);
            __builtin_amdgcn_sched_barrier(0);
            S[0][6] = MFMA16(fk1[0], va[0], S[0][6] * fe1[0]); S[1][6] = MFMA16(fk1[0], va[1], S[1][6] * fe1[0]);
            S[0][7] = MFMA16(fk1[1], va[0], S[0][7] * fe1[1]); S[1][7] = MFMA16(fk1[1], va[1], S[1][7] * fe1[1]);
            __builtin_amdgcn_sched_barrier(0);
            BAR_RAW();
#pragma unroll
            for (int n = 0; n < 2; ++n)
#pragma unroll
                for (int mt = 0; mt < 2; ++mt)
#pragma unroll
                    for (int e = 0; e < 4; ++e) ((LAS float*)(L + OT))[(16 * mt + 4 * g + e) * 132 + 32 * wave + 16 * n + r] = o[n][mt][e];
            if (ch + 2 < 128) { if (wave < 3) asm volatile("s_waitcnt vmcnt(7)" ::: "memory"); else asm volatile("s_waitcnt vmcnt(6)" ::: "memory"); }
            else asm volatile("s_waitcnt vmcnt(0)" ::: "memory");
            BAR_RAW();
            if (ch + 3 < 128) HG_DMA(ch + 3, 1);
        }

            if (c3 + 2 >= 128) break;
        {
            const int ch = c3 + 2;
            LAS unsigned char* B0 = L + 2 * BUF;
            bf16x8 va[2];
            va[0] = *(const LAS bf16x8*)(L + VB + 2 * 8192 + (size_t)((2 * wave + 0) * 64 + lane) * 16); va[1] = *(const LAS bf16x8*)(L + VB + 2 * 8192 + (size_t)((2 * wave + 1) * 64 + lane) * 16);
            __builtin_amdgcn_sched_barrier(0);
            bf16x8 Sb[2][4];
#pragma unroll
            for (int n = 0; n < 2; ++n)
#pragma unroll
                for (int kb = 0; kb < 4; ++kb) Sb[n][kb] = pack_b(S[n][2 * kb], S[n][2 * kb + 1]);
            const LAS unsigned char* B0l = B0 + lane * 16;
            bf16x8 fq0[5], fq1[5]; f32x4 o[2][2];
            bf16x8 fk0[2], fk1[2]; f32x4 fe0[2], fe1[2];
            fq0[0] = *(const LAS bf16x8*)(B0l + 0*1024); fq0[1] = *(const LAS bf16x8*)(B0l + 1*1024); fq0[2] = *(const LAS bf16x8*)(B0l + 2*1024); fq0[3] = *(const LAS bf16x8*)(B0l + 3*1024); fq0[4] = *(const LAS bf16x8*)(B0l + 16384 + 0*1024);
            fq1[0] = *(const LAS bf16x8*)(B0l + 4*1024); fq1[1] = *(const LAS bf16x8*)(B0l + 5*1024); fq1[2] = *(const LAS bf16x8*)(B0l + 6*1024); fq1[3] = *(const LAS bf16x8*)(B0l + 7*1024); fq1[4] = *(const LAS bf16x8*)(B0l + 16384 + 1*1024);
            __builtin_amdgcn_sched_barrier(0);
            { f32x4 c0 = {0.f, 0.f, 0.f, 0.f}, c1 = {0.f, 0.f, 0.f, 0.f};
              c0 = MFMA16(fq0[0], Sb[0][0], c0); c1 = MFMA16(fq0[0], Sb[1][0], c1);
              c0 = MFMA16(fq0[1], Sb[0][1], c0); c1 = MFMA16(fq0[1], Sb[1][1], c1);
              c0 = MFMA16(fq0[2], Sb[0][2], c0); c1 = MFMA16(fq0[2], Sb[1][2], c1);
              c0 = MFMA16(fq0[3], Sb[0][3], c0); c1 = MFMA16(fq0[3], Sb[1][3], c1);
              o[0][0] = MFMA16(fq0[4], va[0], c0); o[1][0] = MFMA16(fq0[4], va[1], c1); }
            fk0[0] = *(const LAS bf16x8*)(B0l + 8192 + 0*1024); fe0[0] = *(const LAS f32x4*)(B0 + 18432 + (16 * 0 + 4 * g) * 4); fk0[1] = *(const LAS bf16x8*)(B0l + 8192 + 1*1024); fe0[1] = *(const LAS f32x4*)(B0 + 18432 + (16 * 1 + 4 * g) * 4);
            __builtin_amdgcn_sched_barrier(0);
            { f32x4 c0 = {0.f, 0.f, 0.f, 0.f}, c1 = {0.f, 0.f, 0.f, 0.f};
              c0 = MFMA16(fq1[0], Sb[0][0], c0); c1 = MFMA16(fq1[0], Sb[1][0], c1);
              c0 = MFMA16(fq1[1], Sb[0][1], c0); c1 = MFMA16(fq1[1], Sb[1][1], c1);
              c0 = MFMA16(fq1[2], Sb[0][2], c0); c1 = MFMA16(fq1[2], Sb[1][2], c1);
              c0 = MFMA16(fq1[3], Sb[0][3], c0); c1 = MFMA16(fq1[3], Sb[1][3], c1);
              o[0][1] = MFMA16(fq1[4], va[0], c0); o[1][1] = MFMA16(fq1[4], va[1], c1); }
            fk1[0] = *(const LAS bf16x8*)(B0l + 8192 + 2*1024); fe1[0] = *(const LAS f32x4*)(B0 + 18432 + (16 * 2 + 4 * g) * 4); fk1[1] = *(const LAS bf16x8*)(B0l + 8192 + 3*1024); fe1[1] = *(const LAS f32x4*)(B0 + 18432 + (16 * 3 + 4 * g) * 4);
            __builtin_amdgcn_sched_barrier(0);
            S[0][0] = MFMA16(fk0[0], va[0], S[0][0] * fe0[0]); S[1][0] = MFMA16(fk0[0], va[1], S[1][0] * fe0[0]);
            S[0][1] = MFMA16(fk0[1], va[0], S[0][1] * fe0[1]); S[1][1] = MFMA16(fk0[1], va[1], S[1][1] * fe0[1]);
            __builtin_amdgcn_sched_barrier(0);
            fk0[0] = *(const LAS bf16x8*)(B0l + 8192 + 4*1024); fe0[0] = *(const LAS f32x4*)(B0 + 18432 + (16 * 4 + 4 * g) * 4); fk0[1] = *(const LAS bf16x8*)(B0l + 8192 + 5*1024); fe0[1] = *(const LAS f32x4*)(B0 + 18432 + (16 * 5 + 4 * g) * 4);
            __builtin_amdgcn_sched_barrier(0);
            S[0][2] = MFMA16(fk1[0], va[0], S[0][2] * fe1[0]); S[1][2] = MFMA16(fk1[0], va[1], S[1][2] * fe1[0]);
            S[0][3] = MFMA16(fk1[1], va[0], S[0][3] * fe1[1]); S[1][3] = MFMA16(fk1[1], va[1], S[1][3] * fe1[1]);
            __builtin_amdgcn_sched_barrier(0);
            fk1[0] = *(const LAS bf16x8*)(B0l + 8192 + 6*1024); fe1[0] = *(const LAS f32x4*)(B0 + 18432 + (16 * 6 + 4 * g) * 4); fk1[1] = *(const LAS bf16x8*)(B0l + 8192 + 7*1024); fe1[1] = *(const LAS f32x4*)(B0 + 18432 + (16 * 7 + 4 * g) * 4);
            __builtin_amdgcn_sched_barrier(0);
            S[0][4] = MFMA16(fk0[0], va[0], S[0][4] * fe0[0]); S[1][4] = MFMA16(fk0[0], va[1], S[1][4] * fe0[0]);
            S[0][5] = MFMA16(fk0[1], va[0], S[0][5] * fe0[1]); S[1][5] = MFMA16(fk0[1], va[1], S[1][5] * fe0[1]);
            __builtin_amdgcn_sched_barrier(0);
            __builtin_amdgcn_sched_barrier(0);
            S[0][6] = MFMA16(fk1[0], va[0], S[0][6] * fe1[0]); S[1][6] = MFMA16(fk1[0], va[1], S[1][6] * fe1[0]);
            S[0][7] = MFMA16(fk1[1], va[0], S[0][7] * fe1[1]); S[1][7] = MFMA16(fk1[1], va[1], S[1][7] * fe1[1]);
            __builtin_amdgcn_sched_barrier(0);
            BAR_RAW();
#pragma unroll
            for (int n = 0; n < 2; ++n)
#pragma unroll
                for (int mt = 0; mt < 2; ++mt)
#pragma unroll
                    for (int e = 0; e < 4; ++e) ((LAS float*)(L + OT))[(16 * mt + 4 * g + e) * 132 + 32 * wave + 16 * n + r] = o[n][mt][e];
            if (ch + 2 < 128) { if (wave < 3) asm volatile("s_waitcnt vmcnt(7)" ::: "memory"); else asm volatile("s_waitcnt vmcnt(6)" ::: "memory"); }
            else asm volatile("s_waitcnt vmcnt(0)" ::: "memory");
            BAR_RAW();
            if (ch + 3 < 128) HG_DMA(ch + 3, 2);
        }
        }
#undef HG_DMA
        BAR_RAW(); BAR_RAW();
    } else {
        const int ht = tid - 256, nt_t = ht >> 3, nt_c0 = 16 * (ht & 7);
        const bf16* P = (const bf16*)(F.ws + WS_P); bf16* MIX = (bf16*)(F.ws + WS_MIX);
        const float* gain = F.in[14] + layer * 128 + nt_c0;
        f32x4 gn[4];
#pragma unroll
        for (int q4 = 0; q4 < 4; ++q4) gn[q4] = *(const GAS f32x4*)(gain + 4 * q4);
        const bf16* zbase = P + ((size_t)b * SEQ + nt_t) * NP + PB_G + h * 128 + nt_c0;
        v4u za[2] = {(v4u){0u, 0u, 0u, 0u}, (v4u){0u, 0u, 0u, 0u}}, zb[2] = {(v4u){0u, 0u, 0u, 0u}, (v4u){0u, 0u, 0u, 0u}};
#pragma unroll 1
        for (int c2 = 0; c2 < 130; c2 += 2) {
        {
            const int ch = c2;
            const int cz = (ch < 128) ? ch : 127;
            zb[0] = *(const GAS v4u*)(zbase + (size_t)cz * 32 * NP); zb[1] = *(const GAS v4u*)(zbase + (size_t)cz * 32 * NP + 8);
            __builtin_amdgcn_sched_barrier(0);
            if (ch > 0) {
                const size_t m = (size_t)b * SEQ + (ch - 1) * 32 + nt_t;
                const LAS float* op = (const LAS float*)(L + OT) + nt_t * 132 + nt_c0;
                f32x4 x[4]; float ss = 0.f;
#pragma unroll
                for (int q4 = 0; q4 < 4; ++q4) { x[q4] = *(const LAS f32x4*)(op + 4 * q4); ss += (x[q4].x * x[q4].x + x[q4].y * x[q4].y) + (x[q4].z * x[q4].z + x[q4].w * x[q4].w); }
                ss += __shfl_xor(ss, 1); ss += __shfl_xor(ss, 2); ss += __shfl_xor(ss, 4);
                const float rs = frsq(ss * (1.f / 128.f) + EPS);
                bf16* mp = MIX + m * D + MIX_B + h * 128 + nt_c0;
#pragma unroll
                for (int i = 0; i < 2; ++i) {
                    const f32x4 xa = x[2 * i] * rs * gn[2 * i], xb = x[2 * i + 1] * rs * gn[2 * i + 1];
                    v4u w;
                    w.x = pk2(xa.x * silu(bflo(za[i].x)), xa.y * silu(bfhi(za[i].x))); w.y = pk2(xa.z * silu(bflo(za[i].y)), xa.w * silu(bfhi(za[i].y)));
                    w.z = pk2(xb.x * silu(bflo(za[i].z)), xb.y * silu(bfhi(za[i].z))); w.w = pk2(xb.z * silu(bflo(za[i].w)), xb.w * silu(bfhi(za[i].w)));
                    *(GAS v4u*)(mp + 8 * i) = w;
                }
            }
            BAR_RAW();
            BAR_RAW();
        }

            if (c2 + 1 > 128) break;
        {
            const int ch = c2 + 1;
            const int cz = (ch < 128) ? ch : 127;
            za[0] = *(const GAS v4u*)(zbase + (size_t)cz * 32 * NP); za[1] = *(const GAS v4u*)(zbase + (size_t)cz * 32 * NP + 8);
            __builtin_amdgcn_sched_barrier(0);
            if (ch > 0) {
                const size_t m = (size_t)b * SEQ + (ch - 1) * 32 + nt_t;
                const LAS float* op = (const LAS float*)(L + OT) + nt_t * 132 + nt_c0;
                f32x4 x[4]; float ss = 0.f;
#pragma unroll
                for (int q4 = 0; q4 < 4; ++q4) { x[q4] = *(const LAS f32x4*)(op + 4 * q4); ss += (x[q4].x * x[q4].x + x[q4].y * x[q4].y) + (x[q4].z * x[q4].z + x[q4].w * x[q4].w); }
                ss += __shfl_xor(ss, 1); ss += __shfl_xor(ss, 2); ss += __shfl_xor(ss, 4);
                const float rs = frsq(ss * (1.f / 128.f) + EPS);
                bf16* mp = MIX + m * D + MIX_B + h * 128 + nt_c0;
#pragma unroll
                for (int i = 0; i < 2; ++i) {
                    const f32x4 xa = x[2 * i] * rs * gn[2 * i], xb = x[2 * i + 1] * rs * gn[2 * i + 1];
                    v4u w;
                    w.x = pk2(xa.x * silu(bflo(zb[i].x)), xa.y * silu(bfhi(zb[i].x))); w.y = pk2(xa.z * silu(bflo(zb[i].y)), xa.w * silu(bfhi(zb[i].y)));
                    w.z = pk2(xb.x * silu(bflo(zb[i].z)), xb.y * silu(bfhi(zb[i].z))); w.w = pk2(xb.z * silu(bflo(zb[i].w)), xb.w * silu(bfhi(zb[i].w)));
                    *(GAS v4u*)(mp + 8 * i) = w;
                }
            }
            BAR_RAW();
            BAR_RAW();
        }

        }
    }
}
#ifndef BAR_LDS
#define BAR_LDS() do { asm volatile("s_waitcnt lgkmcnt(0)" ::: "memory"); __builtin_amdgcn_s_barrier(); asm volatile("" ::: "memory"); } while (0)
#endif
#define MFMA32(a, b, c) __builtin_amdgcn_mfma_f32_32x32x16_bf16((a), (b), (c), 0, 0, 0)
DI int crow32(int reg, int hh) { return (reg & 3) + 8 * (reg >> 2) + 4 * hh; }
DI void attn_unit(const Frame& F, int bh, int qi, int layer) {
    const int b = bh >> 2, h = bh & 3, tid = F.tid, lane = F.lane, wave = F.wave, c = wave >> 2, qs = wave & 3, r32 = lane & 31, hh = lane >> 5;
    LAS unsigned char* L = F.lds;
    constexpr int BUF = 32768, CB = 65536;
    const unsigned char* kf0 = F.ws + WS_KF + ((size_t)bh * 2 + 0) * 64 * 8192; const unsigned char* kf1 = F.ws + WS_KF + ((size_t)bh * 2 + 1) * 64 * 8192;
    const unsigned char* vf = F.ws + WS_VF + (size_t)bh * 64 * 16384;
    const int tq = 128 * qi + 32 * qs + r32;
    const int tw0 = 128 * qi + 32 * qs;
    bf16x8 qf[4];
    {
        const bf16* q = (const bf16*)(F.ws + WS_QR) + (((size_t)bh * 2 + c) * SEQ + tq) * 64 + 8 * hh;
#pragma unroll
        for (int s = 0; s < 4; ++s) qf[s] = *(const GAS bf16x8*)(q + 16 * s);
    }
#pragma unroll
    for (int s = 0; s < 4; ++s) asm volatile("" : "+v"(qf[s]));
    f32x16 O[4];
#pragma unroll
    for (int i = 0; i < 4; ++i)
#pragma unroll
        for (int e = 0; e < 16; ++e) O[i][e] = 0.f;
    float mrun = -__builtin_inff(), lrun = 0.f;
    const int ntile = 2 * qi + 2;
    v4u pa[4], pb4[4];
    {
        const int o = tid * 16;
        pa[0] = *(const GAS v4u*)(kf0 + o); pa[1] = *(const GAS v4u*)(kf1 + o); pa[2] = *(const GAS v4u*)(vf + o); pa[3] = *(const GAS v4u*)(vf + 8192 + o);
        pb4[0] = *(const GAS v4u*)(kf0 + 8192 + o); pb4[1] = *(const GAS v4u*)(kf1 + 8192 + o); pb4[2] = *(const GAS v4u*)(vf + 16384 + o); pb4[3] = *(const GAS v4u*)(vf + 16384 + 8192 + o);
        *(LAS v4u*)(L + o) = pa[0]; *(LAS v4u*)(L + 8192 + o) = pa[1]; *(LAS v4u*)(L + 16384 + o) = pa[2]; *(LAS v4u*)(L + 24576 + o) = pa[3];
    }
    BAR_LDS();
#pragma unroll 1
    for (int j2i = 0; j2i < ntile; j2i += 2) {
        {
        const int j = j2i;
        LAS unsigned char* B0 = L + (j & 1) * BUF; LAS unsigned char* B1 = L + ((j + 1) & 1) * BUF;
        {
            const int j2 = (j + 2 < ntile) ? j + 2 : ntile - 1;
            const size_t o = (size_t)tid * 16;
            pa[0] = *(const GAS v4u*)(kf0 + (size_t)j2 * 8192 + o); pa[1] = *(const GAS v4u*)(kf1 + (size_t)j2 * 8192 + o);
            pa[2] = *(const GAS v4u*)(vf + (size_t)j2 * 16384 + o); pa[3] = *(const GAS v4u*)(vf + (size_t)j2 * 16384 + 8192 + o);
        }
        __builtin_amdgcn_sched_barrier(0);
        const int k0 = 64 * j;
        if (k0 <= tw0 + 31) {
            f32x16 St[2];
            const LAS unsigned char* Bl = B0 + lane * 16;
            bf16x8 kf[8];
#pragma unroll
            for (int i = 0; i < 8; ++i) kf[i] = *(const LAS bf16x8*)(Bl + c * 8192 + i * 1024);
            __builtin_amdgcn_sched_barrier(0);
#pragma unroll
            for (int kb = 0; kb < 2; ++kb) {
#pragma unroll
                for (int e = 0; e < 16; ++e) St[kb][e] = 0.f;
#pragma unroll
                for (int s = 0; s < 4; ++s) St[kb] = MFMA32(kf[kb * 4 + s], qf[s], St[kb]);
            }
            bf16x8 vf0[8], vf1[8];
#pragma unroll
            for (int i = 0; i < 8; ++i) vf0[i] = *(const LAS bf16x8*)(Bl + 16384 + i * 1024);
            __builtin_amdgcn_sched_barrier(0);
            if (k0 + 63 > tw0) {
#pragma unroll
                for (int kb = 0; kb < 2; ++kb)
#pragma unroll
                    for (int e = 0; e < 16; ++e) { const int key = k0 + 32 * kb + crow32(e, hh); if (key > tq) St[kb][e] = -__builtin_inff(); }
            }
            float mx = St[0][0];
#pragma unroll
            for (int kb = 0; kb < 2; ++kb)
#pragma unroll
                for (int e = 0; e < 16; ++e) mx = fmaxf(mx, St[kb][e]);
            mx = fmaxf(mx, __shfl_xor(mx, 32));
            const float mnew = fmaxf(mrun, mx);
            const float alpha = fexp2(mrun - mnew);
            mrun = mnew;
            float ps = 0.f;
#pragma unroll
            for (int kb = 0; kb < 2; ++kb)
#pragma unroll
                for (int e = 0; e < 16; ++e) { const float p = fexp2(St[kb][e] - mnew); St[kb][e] = p; ps += p; }
            lrun = lrun * alpha + ps;
#pragma unroll
            for (int i = 0; i < 4; ++i)
#pragma unroll
                for (int e = 0; e < 16; ++e) O[i][e] *= alpha;
            bf16x8 pb[2][2];
#pragma unroll
            for (int kb = 0; kb < 2; ++kb)
#pragma unroll
                for (int s = 0; s < 2; ++s) { v4u w; w.x = pk2(St[kb][8 * s], St[kb][8 * s + 1]); w.y = pk2(St[kb][8 * s + 2], St[kb][8 * s + 3]); w.z = pk2(St[kb][8 * s + 4], St[kb][8 * s + 5]); w.w = pk2(St[kb][8 * s + 6], St[kb][8 * s + 7]);
                    pb[kb][s] = __builtin_bit_cast(bf16x8, w); }
#pragma unroll
            for (int i = 0; i < 8; ++i) vf1[i] = *(const LAS bf16x8*)(Bl + 16384 + (8 + i) * 1024);
            __builtin_amdgcn_sched_barrier(0);
#pragma unroll
            for (int dvb = 0; dvb < 2; ++dvb)
#pragma unroll
                for (int kb = 0; kb < 2; ++kb)
#pragma unroll
                    for (int s = 0; s < 2; ++s) O[dvb] = MFMA32(vf0[(dvb * 2 + kb) * 2 + s], pb[kb][s], O[dvb]);
            __builtin_amdgcn_sched_barrier(0);
#pragma unroll
            for (int dvb = 0; dvb < 2; ++dvb)
#pragma unroll
                for (int kb = 0; kb < 2; ++kb)
#pragma unroll
                    for (int s = 0; s < 2; ++s) O[2 + dvb] = MFMA32(vf1[(dvb * 2 + kb) * 2 + s], pb[kb][s], O[2 + dvb]);
        }
        if (j + 1 < ntile) {
            const int o = tid * 16;
            *(LAS v4u*)(B1 + o) = pb4[0]; *(LAS v4u*)(B1 + 8192 + o) = pb4[1]; *(LAS v4u*)(B1 + 16384 + o) = pb4[2]; *(LAS v4u*)(B1 + 24576 + o) = pb4[3];
        }
        BAR_LDS();
        }

        {
        const int j = j2i + 1;
        LAS unsigned char* B0 = L + (j & 1) * BUF; LAS unsigned char* B1 = L + ((j + 1) & 1) * BUF;
        {
            const int j2 = (j + 2 < ntile) ? j + 2 : ntile - 1;
            const size_t o = (size_t)tid * 16;
            pb4[0] = *(const GAS v4u*)(kf0 + (size_t)j2 * 8192 + o); pb4[1] = *(const GAS v4u*)(kf1 + (size_t)j2 * 8192 + o);
            pb4[2] = *(const GAS v4u*)(vf + (size_t)j2 * 16384 + o); pb4[3] = *(const GAS v4u*)(vf + (size_t)j2 * 16384 + 8192 + o);
        }
        __builtin_amdgcn_sched_barrier(0);
        const int k0 = 64 * j;
        if (k0 <= tw0 + 31) {
            f32x16 St[2];
            const LAS unsigned char* Bl = B0 + lane * 16;
            bf16x8 kf[8];
#pragma unroll
            for (int i = 0; i < 8; ++i) kf[i] = *(const LAS bf16x8*)(Bl + c * 8192 + i * 1024);
            __builtin_amdgcn_sched_barrier(0);
#pragma unroll
            for (int kb = 0; kb < 2; ++kb) {
#pragma unroll
                for (int e = 0; e < 16; ++e) St[kb][e] = 0.f;
#pragma unroll
                for (int s = 0; s < 4; ++s) St[kb] = MFMA32(kf[kb * 4 + s], qf[s], St[kb]);
            }
            bf16x8 vf0[8], vf1[8];
#pragma unroll
            for (int i = 0; i < 8; ++i) vf0[i] = *(const LAS bf16x8*)(Bl + 16384 + i * 1024);
            __builtin_amdgcn_sched_barrier(0);
            if (k0 + 63 > tw0) {
#pragma unroll
                for (int kb = 0; kb < 2; ++kb)
#pragma unroll
                    for (int e = 0; e < 16; ++e) { const int key = k0 + 32 * kb + crow32(e, hh); if (key > tq) St[kb][e] = -__builtin_inff(); }
            }
            float mx = St[0][0];
#pragma unroll
            for (int kb = 0; kb < 2; ++kb)
#pragma unroll
                for (int e = 0; e < 16; ++e) mx = fmaxf(mx, St[kb][e]);
            mx = fmaxf(mx, __shfl_xor(mx, 32));
            const float mnew = fmaxf(mrun, mx);
            const float alpha = fexp2(mrun - mnew);
            mrun = mnew;
            float ps = 0.f;
#pragma unroll
            for (int kb = 0; kb < 2; ++kb)
#pragma unroll
                for (int e = 0; e < 16; ++e) { const float p = fexp2(St[kb][e] - mnew); St[kb][e] = p; ps += p; }
            lrun = lrun * alpha + ps;
#pragma unroll
            for (int i = 0; i < 4; ++i)
#pragma unroll
                for (int e = 0; e < 16; ++e) O[i][e] *= alpha;
            bf16x8 pb[2][2];
#pragma unroll
            for (int kb = 0; kb < 2; ++kb)
#pragma unroll
                for (int s = 0; s < 2; ++s) { v4u w; w.x = pk2(St[kb][8 * s], St[kb][8 * s + 1]); w.y = pk2(St[kb][8 * s + 2], St[kb][8 * s + 3]); w.z = pk2(St[kb][8 * s + 4], St[kb][8 * s + 5]); w.w = pk2(St[kb][8 * s + 6], St[kb][8 * s + 7]);
                    pb[kb][s] = __builtin_bit_cast(bf16x8, w); }
#pragma unroll
            for (int i = 0; i < 8; ++i) vf1[i] = *(const LAS bf16x8*)(Bl + 16384 + (8 + i) * 1024);
            __builtin_amdgcn_sched_barrier(0);
#pragma unroll
            for (int dvb = 0; dvb < 2; ++dvb)
#pragma unroll
                for (int kb = 0; kb < 2; ++kb)
#pragma unroll
                    for (int s = 0; s < 2; ++s) O[dvb] = MFMA32(vf0[(dvb * 2 + kb) * 2 + s], pb[kb][s], O[dvb]);
            __builtin_amdgcn_sched_barrier(0);
#pragma unroll
            for (int dvb = 0; dvb < 2; ++dvb)
#pragma unroll
                for (int kb = 0; kb < 2; ++kb)
#pragma unroll
                    for (int s = 0; s < 2; ++s) O[2 + dvb] = MFMA32(vf1[(dvb * 2 + kb) * 2 + s], pb[kb][s], O[2 + dvb]);
        }
        if (j + 1 < ntile) {
            const int o = tid * 16;
            *(LAS v4u*)(B1 + o) = pa[0]; *(LAS v4u*)(B1 + 8192 + o) = pa[1]; *(LAS v4u*)(B1 + 16384 + o) = pa[2]; *(LAS v4u*)(B1 + 24576 + o) = pa[3];
        }
        BAR_LDS();
        }

    }
    lrun += __shfl_xor(lrun, 32);
    const float* lamp = (const float*)(F.ws + WS_LBS + 16384);
    const float lam = lamp[2 * layer], li = lamp[2 * layer + 1];
    const float inv = (c == 0) ? frcp(lrun) : lam * frcp(lrun);
    LAS float* cb = (LAS float*)(L + CB) + (32 * qs + r32) * 132;
    if (c == 1) {
#pragma unroll
        for (int dvb = 0; dvb < 4; ++dvb)
#pragma unroll
            for (int q4 = 0; q4 < 4; ++q4) *(LAS f32x4*)(cb + 32 * dvb + 8 * q4 + 4 * hh) = (f32x4){O[dvb][4 * q4] * inv, O[dvb][4 * q4 + 1] * inv, O[dvb][4 * q4 + 2] * inv, O[dvb][4 * q4 + 3] * inv};
    }
    LDS_WAIT(); __syncthreads();
    if (c == 0) {
        float ss = 0.f;
#pragma unroll
        for (int dvb = 0; dvb < 4; ++dvb)
#pragma unroll
            for (int q4 = 0; q4 < 4; ++q4) { const f32x4 o1 = *(const LAS f32x4*)(cb + 32 * dvb + 8 * q4 + 4 * hh);
#pragma unroll
                for (int e = 0; e < 4; ++e) { const float v = O[dvb][4 * q4 + e] * inv - o1[e]; O[dvb][4 * q4 + e] = v; ss += v * v; } }
        ss += __shfl_xor(ss, 32);
        const float rs = frsq(ss * (1.f / 128.f) + EPS) * (1.f - li);
        const float* gain = F.in[12] + layer * 128;
        bf16* mp = (bf16*)(F.ws + WS_MIX) + ((size_t)b * SEQ + tq) * D + MIX_A + h * 128;
        f32x4 gnv[16];
#pragma unroll
        for (int i = 0; i < 16; ++i) gnv[i] = *(const GAS f32x4*)(gain + 32 * (i >> 2) + 8 * (i & 3) + 4 * hh);
#pragma unroll
        for (int dvb = 0; dvb < 4; ++dvb)
#pragma unroll
            for (int q4 = 0; q4 < 4; ++q4) { const int dv = 32 * dvb + 8 * q4 + 4 * hh; const f32x4 gn = gnv[dvb * 4 + q4];
                v2u w; w.x = pk2(O[dvb][4 * q4] * rs * gn.x, O[dvb][4 * q4 + 1] * rs * gn.y); w.y = pk2(O[dvb][4 * q4 + 2] * rs * gn.z, O[dvb][4 * q4 + 3] * rs * gn.w);
                *(GAS v2u*)(mp + dv) = w; }
    }
    LDS_WAIT(); __syncthreads();
}
DI void attn_phase(const Frame& F, int qslot) {
    const int layer = qslot & 3;
    for (;;) {
        if (F.tid == 0) F.MISC[0] = __hip_atomic_fetch_add((unsigned*)(F.ctl + CW_QUEUE + 64 * qslot), 1u, RLX_AGENT);
        LDS_WAIT(); __syncthreads();
        const int u = (int)F.MISC[0];
        __syncthreads();
        if (u >= 256) break;
        attn_unit(F, u & 7, 31 - (u >> 3), layer);
    }
}
struct Args { const float* in[24]; float* out; unsigned char* ws; int ph_lo, ph_hi; };

#ifndef PROBE_DUP
#define PROBE_DUP 0
#endif
#ifndef PROBE_VAR
#define PROBE_VAR 0
#endif
#ifndef GEMM_SP2
#define GEMM_SP2 true
#endif
#ifndef RESID_ALIGN
#define RESID_ALIGN false
#endif
#define REPS(bit) (((PROBE_DUP >> (bit)) & 1) ? 2 : 1)
#define REP_SEAM(rep, bit) do { if ((rep) + 1 < REPS(bit)) xcd_barrier(bar); } while (0)
__global__ void __launch_bounds__(512, 2) mega_fwd(Args args) {
    extern __shared__ __attribute__((aligned(16))) unsigned char lds[];
    Frame F;
    F.lds = (LAS unsigned char*)lds;
    F.MISC = (volatile LAS unsigned*)(F.lds + MISC_OFF);
    F.tid = threadIdx.x; F.lane = F.tid & 63; F.wave = __builtin_amdgcn_readfirstlane(F.tid >> 6);
    F.G = gridDim.x; { const int bx = blockIdx.x; F.vcu = (F.G % 8 == 0) ? (bx % 8) * (F.G / 8) + bx / 8 : bx; }
    F.ws = args.ws; F.ctl = (gu32*)(args.ws + WS_CTL); F.out = args.out;
    F.in = (const CAS cfptr*)__builtin_amdgcn_kernarg_segment_ptr();
    if (F.tid < 64) F.MISC[F.tid] = 0u;
    __syncthreads();
    XcdBarrier bar; bar.bar = (unsigned*)(F.ctl + CW_BAR); bar.x = 0; bar.st = nullptr;
#if !MK_PER_PHASE
    bar = xcd_barrier_post((unsigned*)(F.ctl + CW_BAR), F.MISC + 8);
#endif
    const int lo = args.ph_lo, hi = args.ph_hi;
    int ph = 0;
#define IN_PH() (lo <= ph && ph < hi)
#if MK_PER_PHASE
#define SEAM() do { ++ph; } while (0)
#else
#define SEAM() do { if (lo <= ph && ph + 1 < hi) { xcd_barrier(bar); if ((PROBE_DUP >> 14) & 1) xcd_barrier(bar); } ++ph; } while (0)
#endif
#define PH(Fp) Frame Fp = F; { int t_; asm volatile("v_mbcnt_lo_u32_b32 %0, -1, 0\n\tv_mbcnt_hi_u32_b32 %0, -1, %0" : "=v"(t_)); t_ += F.wave * 64; asm volatile("" : "+v"(t_));     Fp.tid = t_; Fp.lane = t_ & 63; Fp.wave = __builtin_amdgcn_readfirstlane(t_ >> 6); \
        unsigned char* w_ = F.ws; asm volatile("" : "+s"(w_)); Fp.ws = w_; Fp.ctl = (gu32*)(w_ + WS_CTL); float* o_ = F.out; asm volatile("" : "+s"(o_)); Fp.out = o_; \
        const CAS cfptr* i_ = F.in; asm volatile("" : "+s"(i_)); Fp.in = i_; }
#ifndef SKIP_PRO
    if (IN_PH()) for (int rep = 0; rep < REPS(0); ++rep) { PH(Fp); p0_prologue(Fp, (rep + 1 < REPS(0)) ? PROBE_VAR : 0); REP_SEAM(rep, 0); }
#endif
    SEAM();
#pragma unroll 1
    for (int f = 0; f < NFFN; ++f) {
        const int l = f >> 1, s = f & 1;
        const int vin = 3 * l + (s ? 2 : 0);
        if (IN_PH()) for (int rep = 0; rep < REPS(1); ++rep) {
            PH(Fp);
            pg8::Gemm g{(const bf16*)(Fp.ws + WS_XB), (const bf16*)(Fp.ws + WS_WGU + (size_t)f * SZ_WGU1), M, NGU, D}; pg8::StaticOrder S; S.init(M, NGU, Fp.G, (int)blockIdx.x);
            pg8::EpiGateUp E{(bf16*)(Fp.ws + WS_ACT), rowsq_ptr(Fp, vin), DFF};
#ifndef SKIP_GEMM
            pg8::gemm_phase<pg8::EpiGateUp, pg8::StaticOrder, true, GEMM_SP2>(Fp.lds, g, S, E, Fp.tid);
#endif
            if (Fp.G == 256 && blockIdx.x >= 128 && rep == 0) {
                PH(Fc); int lo_, hi_; cv_slot(l, s ? 3 : 0, lo_, hi_);
                convert_range(Fc, lo_, hi_, ((int)blockIdx.x - 128) * 8 + Fc.wave, 128 * 8, (LAS float*)(Fc.lds + Fc.wave * 16896));
            }
            REP_SEAM(rep, 1);
        }
        SEAM();
        if (IN_PH()) for (int rep = 0; rep < REPS(2); ++rep) {
            PH(Fp);
            const bool dummy = rep + 1 < REPS(2);
            pg8::Gemm g{(const bf16*)(Fp.ws + WS_ACT), (const bf16*)(Fp.ws + WS_WD + (size_t)f * SZ_WD1), M, D, DFF}; pg8::StaticOrder S; S.init(M, D, Fp.G, (int)blockIdx.x);
            pg8::EpiResid E{(const bf16*)(Fp.ws + WS_XB), Fp.ws + WS_XLO, (bf16*)(Fp.ws + (dummy ? WS_MIX : WS_XB)), Fp.ws + (dummy ? WS_P : WS_XLO), rowsq_ptr(Fp, dummy ? 13 : vin + 1), dummy ? 0.f : 0.5f};
#ifndef SKIP_GEMM
            pg8::gemm_phase<pg8::EpiResid, pg8::StaticOrder, RESID_ALIGN, GEMM_SP2>(Fp.lds, g, S, E, Fp.tid);
#endif
            REP_SEAM(rep, 2);
        }
        SEAM();
        if (s == 0) {
            if (IN_PH()) for (int rep = 0; rep < REPS(3); ++rep) {
                PH(Fp);
                pg8::Gemm g{(const bf16*)(Fp.ws + WS_XB), (const bf16*)(Fp.ws + WS_WIN + (size_t)l * SZ_WIN1), M, DINP, D}; pg8::StaticOrder S; S.init(M, DINP, Fp.G, (int)blockIdx.x);
                pg8::EpiWin E{(bf16*)(Fp.ws + WS_P), (float*)(Fp.ws + WS_PBA), rowsq_ptr(Fp, 3 * l + 1), NP};
#ifndef SKIP_GEMM
                pg8::gemm_phase<pg8::EpiWin, pg8::StaticOrder, true, GEMM_SP2>(Fp.lds, g, S, E, Fp.tid);
#endif
                if (Fp.G == 256 && blockIdx.x >= 224 && rep == 0) {
                    PH(Fc); int lo_, hi_; cv_slot(l, 1, lo_, hi_);
                    convert_range(Fc, lo_, hi_, ((int)blockIdx.x - 224) * 8 + Fc.wave, 32 * 8, (LAS float*)(Fc.lds + Fc.wave * 16896));
                }
                REP_SEAM(rep, 3);
            }
            SEAM();
            if (IN_PH()) for (int rep = 0; rep < REPS(4); ++rep) {
#ifndef SKIP_GPREP
                for (int r3 = 0; r3 < REPS(11); ++r3) { PH(Fp); for (int j = Fp.vcu; j < 768; j += Fp.G) gdn_prep_job(Fp, j, l, (r3 + 1 < REPS(11)) ? PROBE_VAR : 0); }
#endif
#ifndef SKIP_HPREP
                for (int r3 = 0; r3 < REPS(12); ++r3) { PH(Fp); for (int j = Fp.vcu * 8 + Fp.wave; j < 1536; j += Fp.G * 8) hgrn_prep_job(Fp, j, l, Fp.lds + Fp.wave * 17408); }
#endif
                __syncthreads();
                for (int r3 = 0; r3 < REPS(13); ++r3) { PH(Fp); for (int j = Fp.vcu; j < 512; j += Fp.G) attn_prep_job(Fp, j); if (r3 == 0) gate_pass(Fp, l); }
                REP_SEAM(rep, 4);
            }
            SEAM();
            if (IN_PH()) for (int rep = 0; rep < REPS(5); ++rep) {
#ifndef SKIP_SCAN
                for (int r2 = 0; r2 < REPS(8); ++r2) {
                if (blockIdx.x < 12) { for (int r3 = 0; r3 < REPS(9); ++r3) { PH(Fp); gdn_scan(Fp, (int)blockIdx.x, l, (r3 + 1 < REPS(9)) ? PROBE_VAR : 0); } }
                else if (blockIdx.x < 24) { for (int r3 = 0; r3 < REPS(10); ++r3) { PH(Fp); hgrn_scan(Fp, (int)blockIdx.x - 12, l); } }
                }
#endif
#ifndef SKIP_ATTN
                for (int r2 = 0; r2 < REPS(7); ++r2) { PH(Fp); attn_phase(Fp, l + 4 * rep + 8 * r2); if (r2 + 1 < REPS(7)) xcd_barrier(bar); }
#endif
                if (F.G == 256 && blockIdx.x >= 24 && rep == 0) {
                    PH(Fc); int lo_, hi_; cv_slot(l, 2, lo_, hi_);
                    convert_range(Fc, lo_, hi_, ((int)blockIdx.x - 24) * 8 + Fc.wave, 232 * 8, (LAS float*)(Fc.lds + Fc.wave * 16896));
                }
                REP_SEAM(rep, 5);
            }
            SEAM();
            if (IN_PH()) for (int rep = 0; rep < REPS(6); ++rep) {
                PH(Fp);
                const bool dummy = rep + 1 < REPS(6);
                pg8::Gemm g{(const bf16*)(Fp.ws + WS_MIX), (const bf16*)(Fp.ws + WS_WOUT + (size_t)l * SZ_WOUT1), M, D, D}; pg8::StaticOrder S; S.init(M, D, Fp.G, (int)blockIdx.x);
                pg8::EpiResid E{(const bf16*)(Fp.ws + WS_XB), Fp.ws + WS_XLO, (bf16*)(Fp.ws + (dummy ? WS_ACT : WS_XB)), Fp.ws + (dummy ? WS_P : WS_XLO), rowsq_ptr(Fp, dummy ? 13 : 3 * l + 2), dummy ? 0.f : 1.0f};
    #ifndef SKIP_GEMM
            pg8::gemm_phase<pg8::EpiResid, pg8::StaticOrder, RESID_ALIGN, GEMM_SP2>(Fp.lds, g, S, E, Fp.tid);
#endif
            }
            SEAM();
        }
    }
    if (IN_PH()) {
        PH(Fp);
        const unsigned long long* rq = rowsq_ptr(Fp, 12); const float* w = Fp.in[23];
        const int gw = Fp.vcu * 8 + Fp.wave, NGW = Fp.G * 8;
        for (int m = gw; m < M; m += NGW) {
            const float rs = frsq((float)rq[m] * (1.f / (2048.f * 16777216.f)) + EPS);
            const GAS v2u* hr = (const GAS v2u*)((const bf16*)(Fp.ws + WS_XB) + (size_t)m * D) + Fp.lane; const unsigned char* lrow = Fp.ws + WS_XLO + (size_t)m * D;
            GAS f32x4* xr = (GAS f32x4*)(Fp.out + (size_t)m * D) + Fp.lane; const GAS f32x4* wr = (const GAS f32x4*)w + Fp.lane;
            v2u hv8[8]; unsigned lw8[8]; f32x4 ww8[8];
#pragma unroll
            for (int j = 0; j < 8; ++j) { hv8[j] = hr[64 * j]; ww8[j] = wr[64 * j];
                const int c = 256 * j + 4 * Fp.lane, cl = c & 255, bj = cl >> 7, wc = (cl & 127) >> 5, fq = (cl & 31) >> 3, k = cl & 7;
                lw8[j] = *(const GAS unsigned*)(lrow + (c & ~255) + ((wc * 4 + fq) * 2 + bj) * 8 + k); }
#pragma unroll
            for (int j = 0; j < 8; ++j) { const v2u hv = hv8[j]; const unsigned lw = lw8[j]; const f32x4 ww = ww8[j];
                f32x4 v = {pg8::e_x24(hv.x & 0xffffu, lw & 0xffu), pg8::e_x24(hv.x >> 16, (lw >> 8) & 0xffu), pg8::e_x24(hv.y & 0xffffu, (lw >> 16) & 0xffu), pg8::e_x24(hv.y >> 16, lw >> 24)};
                xr[64 * j] = v * rs * ww; }
        }
    }
#undef IN_PH
#undef SEAM
}

extern "C" void kernel_launch(void* const* d_in, const int* in_sizes, int n_in, void* d_out, int out_size, void* d_ws, size_t ws_size, hipStream_t stream) {
    static int grid = 0;
    if (grid == 0) {
        if (n_in != 24 || out_size != M * D || ws_size < WS_END) { fprintf(stderr, "kernel_launch: unexpected shapes: n_in %d out %d ws %zu (need %zu)\n", n_in, out_size, ws_size, (size_t)WS_END); grid = -1; return; }
        int dev = 0, cus = 0, per_cu = 0;
        if (hipGetDevice(&dev) != hipSuccess || hipDeviceGetAttribute(&cus, hipDeviceAttributeMultiprocessorCount, dev) != hipSuccess) { grid = -1; return; }
        if (hipFuncSetAttribute((const void*)mega_fwd, hipFuncAttributeMaxDynamicSharedMemorySize, LDS_BYTES) != hipSuccess) { fprintf(stderr, "kernel_launch: hipFuncSetAttribute failed\n"); grid = -1; return; }
        if (hipOccupancyMaxActiveBlocksPerMultiprocessor(&per_cu, (const void*)mega_fwd, 512, LDS_BYTES) != hipSuccess || per_cu < 1) { fprintf(stderr, "kernel_launch: occupancy query says %d\n", per_cu); }
        (void)hipGetLastError();
        grid = cus;
    }
    if (grid < 0) return;
    (void)hipMemsetAsync((char*)d_ws + WS_CTL, 0, CTL_ZERO_BYTES, stream);
    Args a{};
    for (int i = 0; i < 24; ++i) a.in[i] = (const float*)d_in[i];
    a.out = (float*)d_out; a.ws = (unsigned char*)d_ws;
    constexpr int NPH = 1 + NFFN * 2 + DEPTH * 4 + 1;
#if MK_PER_PHASE
    for (int p = 0; p < NPH; ++p) { a.ph_lo = p; a.ph_hi = p + 1; hipLaunchKernelGGL(mega_fwd, dim3(grid), dim3(512), LDS_BYTES, stream, a); }
#else
    a.ph_lo = 0; a.ph_hi = NPH;
    hipLaunchKernelGGL(mega_fwd, dim3(grid), dim3(512), LDS_BYTES, stream, a);
#endif
    const hipError_t le = hipPeekAtLastError();
    if (le != hipSuccess) fprintf(stderr, "kernel_launch: launch failed: %s\n", hipGetErrorName(le));
}
```

```cpp
#include <hip/hip_runtime.h>
#include <cstdio>
#include <cstdint>

#ifndef MK_PER_PHASE
#define MK_PER_PHASE 0
#endif

#define PROBE_DUP 0
#define PROBE_VAR 0
#define DI __device__ __forceinline__
#define GAS __attribute__((address_space(1)))
#define LAS __attribute__((address_space(3)))
typedef unsigned short bf16;
typedef unsigned v4u __attribute__((ext_vector_type(4)));
typedef unsigned v2u __attribute__((ext_vector_type(2)));
typedef float f32x4 __attribute__((ext_vector_type(4)));
typedef float f32x2 __attribute__((ext_vector_type(2)));
typedef float f32x16 __attribute__((ext_vector_type(16)));
typedef short bf16x8 __attribute__((ext_vector_type(8)));
typedef short s16x4 __attribute__((ext_vector_type(4)));
typedef __bf16 bf16x2_t __attribute__((ext_vector_type(2)));
typedef GAS unsigned gu32;
#define CAS __attribute__((address_space(4)))
typedef const float* cfptr;
#define RLX_AGENT __ATOMIC_RELAXED, __HIP_MEMORY_SCOPE_AGENT
#define LDS_WAIT() asm volatile("s_waitcnt lgkmcnt(0)" ::: "memory")
#define VM_WAIT() asm volatile("s_waitcnt vmcnt(0)" ::: "memory")

constexpr int BATCH = 2, SEQ = 4096, M = BATCH * SEQ, D = 2048, DEPTH = 4, DFF = 5632, DIN = 7692, DINP = 7936, NP = 7680, NGU = 2 * DFF;
constexpr int NFFN = 2 * DEPTH;
constexpr float EPS = 1e-6f;
constexpr int PA_Q = 0, PA_K = 512, PA_V = 1024, PB_Q = 1536, PB_F = 2304, PB_I = 3072, PB_G = 3840, PC_Q = 4608, PC_K = 5376, PC_V = 6144, PC_Z = 6912;
constexpr int MIX_A = 0, MIX_B = 512, MIX_C = 1280;

DI unsigned pk2(float lo, float hi) { f32x2 v = {lo, hi}; bf16x2_t b = __builtin_convertvector(v, bf16x2_t); return __builtin_bit_cast(unsigned, b); }
DI float bf2f(unsigned v) { return __uint_as_float(v << 16); }
DI float bflo(unsigned w) { return __uint_as_float(w << 16); }
DI float bfhi(unsigned w) { return __uint_as_float(w & 0xffff0000u); }
DI float fexp2(float x) { return __builtin_amdgcn_exp2f(x); }
DI float fexp(float x) { return __builtin_amdgcn_exp2f(x * 1.4426950408889634f); }
DI float flog(float x) { return __builtin_amdgcn_logf(x) * 0.6931471805599453f; }
DI float frcp(float x) { return __builtin_amdgcn_rcpf(x); }
DI float frsq(float x) { return __builtin_amdgcn_rsqf(x); }
DI float sigm(float x) { return frcp(1.f + fexp(-x)); }
DI float silu(float x) { return x * sigm(x); }
DI float softplus(float x) { return fmaxf(x, 0.f) + flog(1.f + fexp(-fabsf(x))); }
DI float wave_sum(float v) {
#pragma unroll
    for (int o = 1; o < 64; o <<= 1) v += __shfl_xor(v, o);
    return v;
}
DI constexpr int permk(int g, int j) { return (j < 4) ? (4 * g + j) : (16 + 4 * g + (j - 4)); }
constexpr size_t MiB = 1u << 20;
constexpr size_t WS_CTL = 0, CTL_ZERO_BYTES = 1 * MiB;
constexpr size_t SZ_WGU1 = (size_t)NGU * D * 2, SZ_WD1 = (size_t)D * DFF * 2, SZ_WIN1 = (size_t)DINP * D * 2, SZ_WOUT1 = (size_t)D * D * 2;
constexpr size_t WS_WGU = 1 * MiB;
constexpr size_t WS_WD = WS_WGU + NFFN * SZ_WGU1;
constexpr size_t WS_WIN = WS_WD + NFFN * SZ_WD1;
constexpr size_t WS_WOUT = WS_WIN + DEPTH * SZ_WIN1;
constexpr size_t WS_XB = WS_WOUT + DEPTH * SZ_WOUT1;
constexpr size_t WS_ACT = WS_XB + (size_t)M * D * 2;
constexpr size_t WS_P = WS_ACT + (size_t)M * DFF * 2;
constexpr size_t WS_PBA = WS_P + (size_t)M * NP * 2;
constexpr size_t WS_MIX = WS_PBA + (size_t)M * 16 * 4;
constexpr size_t WS_ROPE = WS_MIX + (size_t)M * D * 2;
constexpr size_t WS_LBS = WS_ROPE + (size_t)SEQ * 32 * 8;
constexpr size_t WS_QR = WS_LBS + 64 * 1024;
constexpr size_t WS_KF = WS_QR + (size_t)M * 512 * 2;
constexpr size_t WS_VF = WS_KF + (size_t)M * 512 * 2;
constexpr size_t WS_HQ = WS_VF + (size_t)M * 512 * 2;
constexpr size_t WS_HK = WS_HQ + (size_t)12 * 128 * 8192;
constexpr size_t WS_HV = WS_HK + (size_t)12 * 128 * 8192;
constexpr size_t WS_HA = WS_HV + (size_t)12 * 128 * 8192;
constexpr size_t WS_HE = WS_HA + (size_t)12 * 128 * 2048;
constexpr size_t WS_GW = WS_HE + (size_t)12 * 128 * 512;
constexpr size_t WS_GQ = WS_GW + (size_t)12 * 64 * 16384;
constexpr size_t WS_GK = WS_GQ + (size_t)12 * 64 * 16384;
constexpr size_t WS_GA = WS_GK + (size_t)12 * 64 * 16384;
constexpr size_t WS_GU = WS_GA + (size_t)12 * 64 * 8192;
constexpr size_t WS_GE = WS_GU + (size_t)12 * 64 * 32768;
constexpr size_t WS_XLO = WS_GE + 64 * 1024;
constexpr size_t WS_GZ = WS_XLO + (size_t)M * D;
constexpr size_t WS_END = WS_GZ + (size_t)12 * SEQ * 128 * 2;
constexpr int CW_TMO = 0, CW_CODE = 1;
constexpr int CW_QUEUE = 64;
constexpr int CW_BAR = 4096;
constexpr int CW_ROWSQ = 16384;
static_assert(CW_ROWSQ * 4 + 13 * M * 8 <= (int)CTL_ZERO_BYTES, "CTL region");
constexpr int LDS_BYTES = 163840;
constexpr int MISC_OFF = LDS_BYTES - 256;
namespace pg8 {
#define PG8_LAS __attribute__((address_space(3)))
typedef unsigned short bf16_t;
typedef short bf16x8 __attribute__((ext_vector_type(8)));
typedef float f32x4 __attribute__((ext_vector_type(4)));
typedef unsigned u32x4 __attribute__((ext_vector_type(4)));
constexpr int BM = 256, BK = 64, HALF = 128, HTB = HALF * BK * 2  , STAGE_BYTES = 8 * HTB, NXCD = 8, WGM = 8;

__host__ __device__ __forceinline__ int lds_byte(int r, int c) { const int st = (r >> 4) * 2 + (c >> 5), rr = r & 15, cc = c & 31, ob = rr * 64 + cc * 2; return st * 1024 + (ob ^ (((ob >> 9) & 1) << 5)); }
__host__ __device__ __forceinline__ void stage_rc(int b, int& R, int& C) { const int st = b / 1024, sb = b % 1024, swz = sb ^ (((sb >> 9) & 1) << 5); R = (st >> 1) * 16 + swz / 64; C = (st & 1) * 32 + (swz % 64) / 2; }
__host__ __device__ __forceinline__ int perm32(int rho) { const int n = rho >> 4, i = rho & 15; return 8 * (i >> 2) + 4 * n + (i & 3); }

struct Unit { int pm, pn; };
struct Gemm { const bf16_t* A; const bf16_t* Bt; int M, N, K; };

struct StaticOrder {
    int nM, nN, nwg, G, c;
    __host__ __device__ void init(int M, int N, int G_, int c_) { nM = M / BM; nN = N / BM; nwg = nM * nN; G = G_; c = c_; }
    __host__ __device__ bool next(int i, Unit& u) const {
        const long L = (long)i * G + c; if (L >= nwg) return false;
        int wgid = (int)L; { const int q = nwg / NXCD, r = nwg % NXCD, xcd = wgid % NXCD, off = wgid / NXCD; wgid = (xcd < r ? xcd * (q + 1) : r * (q + 1) + (xcd - r) * q) + off; }
        const int nig = WGM * nN, gid = wgid / nig, fm = gid * WGM, gsz = (nM - fm) < WGM ? (nM - fm) : WGM;
        u.pm = fm + ((wgid % nig) % gsz); u.pn = (wgid % nig) / gsz; return true;
    }
    __device__ __forceinline__ void a_ready(const Unit&) const {}
    __device__ __forceinline__ void done(const Unit&) const {}
};

__device__ __forceinline__ unsigned cvt_pk_bf16(float lo, float hi) { unsigned r; asm volatile("v_cvt_pk_bf16_f32 %0, %1, %2" : "=v"(r) : "v"(lo), "v"(hi)); return r; }
#define PG8_GAS __attribute__((address_space(1)))
__device__ __forceinline__ float e_exp(float x) { return __builtin_amdgcn_exp2f(x * 1.4426950408889634f); }
__device__ __forceinline__ float e_silu(float x) { return x * __builtin_amdgcn_rcpf(1.f + e_exp(-x)); }
__device__ __forceinline__ unsigned e_pk2(float lo, float hi) { typedef float f2 __attribute__((ext_vector_type(2))); typedef __bf16 b2 __attribute__((ext_vector_type(2))); f2 v = {lo, hi}; b2 b = __builtin_convertvector(v, b2); return __builtin_bit_cast(unsigned, b); }

struct EpiGateUp {
    static constexpr bool PERM = true, AFTER_DRAIN = false;
    bf16_t* ACT; const unsigned long long* rowsq;
    int ldc;
    __device__ __forceinline__ void operator()(const f32x4 (&acc)[2][2][4][2], const Unit& u, int wr, int wc, int fr, int fq) const {
        const int row0 = u.pm * BM + wr * 64 + fr, col0 = u.pn * HALF + wc * 32 + 8 * fq;
        unsigned long long rq[2][4];
#pragma unroll
        for (int ai = 0; ai < 2; ++ai)
#pragma unroll
            for (int m = 0; m < 4; ++m) rq[ai][m] = ((const PG8_GAS unsigned long long*)rowsq)[row0 + ai * HALF + m * 16];
#pragma unroll
        for (int ai = 0; ai < 2; ++ai)
#pragma unroll
            for (int m = 0; m < 4; ++m) {
                const int row = row0 + ai * HALF + m * 16;
                const float rs = __builtin_amdgcn_rsqf((float)rq[ai][m] * (1.0f / (2048.0f * 16777216.0f)) + 1e-6f);
                float o[8];
#pragma unroll
                for (int n = 0; n < 2; ++n)
#pragma unroll
                    for (int j = 0; j < 4; ++j) { const float g = acc[ai][0][m][n][j] * rs, up = acc[ai][1][m][n][j] * rs; o[4 * n + j] = e_silu(g) * up; }
                u32x4 w; w.x = e_pk2(o[0], o[1]); w.y = e_pk2(o[2], o[3]); w.z = e_pk2(o[4], o[5]); w.w = e_pk2(o[6], o[7]);
                *(PG8_GAS u32x4*)(ACT + (size_t)row * ldc + col0) = w;
            }
    }
};
__device__ __forceinline__ float e_x24(unsigned h16, unsigned l8) { return __uint_as_float(((h16 - (l8 >> 7)) << 16) | (l8 << 8)); }
struct EpiResid {
    static constexpr bool PERM = true, AFTER_DRAIN = false;
    const bf16_t* hin; const unsigned char* lin; bf16_t* hout; unsigned char* lout; unsigned long long* rowsq_out; float scale;
    __device__ __forceinline__ void operator()(const f32x4 (&acc)[2][2][4][2], const Unit& u, int wr, int wc, int fr, int fq) const {
        const int row0 = u.pm * BM + wr * 64 + fr, col0 = u.pn * BM + wc * 32 + 8 * fq, lcol = u.pn * BM + (wc * 4 + fq) * 16;
#pragma unroll
        for (int ai = 0; ai < 2; ++ai) {
            u32x4 L4[4], H4[4][2];
#pragma unroll
            for (int m = 0; m < 4; ++m) {
                const int row = row0 + ai * HALF + m * 16; const size_t off = (size_t)row * 2048 + col0, loff = (size_t)row * 2048 + lcol;
                L4[m] = *(const PG8_GAS u32x4*)(lin + loff); H4[m][0] = *(const PG8_GAS u32x4*)(hin + off); H4[m][1] = *(const PG8_GAS u32x4*)(hin + off + HALF);
            }
#pragma unroll
            for (int m = 0; m < 4; ++m) {
                const int row = row0 + ai * HALF + m * 16; const size_t off = (size_t)row * 2048 + col0, loff = (size_t)row * 2048 + lcol; float ss = 0.f;
                const u32x4 l4 = L4[m];
                u32x4 lo4;
#pragma unroll
                for (int bj = 0; bj < 2; ++bj) {
                    const u32x4 h4 = H4[m][bj];
                    u32x4 ho;
#pragma unroll
                    for (int j = 0; j < 4; ++j) {
                        const unsigned lw = l4[2 * bj + (j >> 1)], lb0 = (lw >> (16 * (j & 1))) & 0xffu, lb1 = (lw >> (16 * (j & 1) + 8)) & 0xffu;
                        const float x0 = e_x24(h4[j] & 0xffffu, lb0) + acc[ai][bj][m][j >> 1][2 * (j & 1)] * scale, x1 = e_x24(h4[j] >> 16, lb1) + acc[ai][bj][m][j >> 1][2 * (j & 1) + 1] * scale;
                        const unsigned b0 = __float_as_uint(x0), b1 = __float_as_uint(x1);
                        ho[j] = ((b0 + 0x8000u) >> 16) | ((b1 + 0x8000u) & 0xffff0000u);
                        const unsigned nb = ((b0 >> 8) & 0xffu) | (b1 & 0xff00u);
                        if ((j & 1) == 0) lo4[2 * bj + (j >> 1)] = nb; else lo4[2 * bj + (j >> 1)] |= nb << 16;
                        ss += x0 * x0 + x1 * x1;
                    }
                    *(PG8_GAS u32x4*)(hout + off + bj * HALF) = ho;
                }
                *(PG8_GAS u32x4*)(lout + loff) = lo4;
                ss += __shfl_xor(ss, 16); ss += __shfl_xor(ss, 32);
                if (fq == 0) __hip_atomic_fetch_add((PG8_GAS unsigned long long*)(rowsq_out + row), (unsigned long long)(ss * 16777216.0f + 0.5f), __ATOMIC_RELAXED, __HIP_MEMORY_SCOPE_AGENT);
            }
        }
    }
};
struct EpiWin {
    static constexpr bool PERM = true, AFTER_DRAIN = false;
    bf16_t* P; float* PBA; const unsigned long long* rowsq; int ldp;
    __device__ __forceinline__ void operator()(const f32x4 (&acc)[2][2][4][2], const Unit& u, int wr, int wc, int fr, int fq) const {
        const int row0 = u.pm * BM + wr * 64 + fr, col0 = u.pn * BM + wc * 32 + 8 * fq;
        const bool tail = (u.pn == 30);
        unsigned long long rq[2][4];
#pragma unroll
        for (int ai = 0; ai < 2; ++ai)
#pragma unroll
            for (int m = 0; m < 4; ++m) rq[ai][m] = ((const PG8_GAS unsigned long long*)rowsq)[row0 + ai * HALF + m * 16];
#pragma unroll
        for (int ai = 0; ai < 2; ++ai)
#pragma unroll
            for (int m = 0; m < 4; ++m) {
                const int row = row0 + ai * HALF + m * 16;
                const float rs = __builtin_amdgcn_rsqf((float)rq[ai][m] * (1.0f / (2048.0f * 16777216.0f)) + 1e-6f);
                if (!tail) {
#pragma unroll
                    for (int bj = 0; bj < 2; ++bj) {
                        const f32x4 v0 = acc[ai][bj][m][0] * rs, v1 = acc[ai][bj][m][1] * rs;
                        u32x4 w; w.x = e_pk2(v0[0], v0[1]); w.y = e_pk2(v0[2], v0[3]); w.z = e_pk2(v1[0], v1[1]); w.w = e_pk2(v1[2], v1[3]);
                        *(PG8_GAS u32x4*)(P + (size_t)row * ldp + col0 + bj * HALF) = w;
                    }
                } else if (wc == 0 && fq < 2) {
                    *(PG8_GAS f32x4*)(PBA + (size_t)row * 16 + 8 * fq) = acc[ai][0][m][0] * rs;
                    *(PG8_GAS f32x4*)(PBA + (size_t)row * 16 + 8 * fq + 4) = acc[ai][0][m][1] * rs;
                }
            }
    }
};
template <class Epi, class Sched, bool ALIGN_EPI = false, bool SP2 = false>
__device__ __forceinline__ void gemm_phase(PG8_LAS unsigned char* lds, const Gemm g, const Sched& S, const Epi& E, const int tid) {
    const int wid = __builtin_amdgcn_readfirstlane(tid >> 6), lane = tid & 63, wr = wid >> 2, wc = wid & 3, fr = lane & 15, fq = lane >> 4;
    const int K = g.K, nt = K / BK;
    unsigned voffA[2], voffB[2];
#pragma unroll
    for (int i = 0; i < 2; ++i) { int R, C; stage_rc(tid * 16 + i * 8192, R, C); const int Rb = Epi::PERM ? ((R & ~31) + perm32(R & 31)) : R;
        voffA[i] = (unsigned)(R * K + C) * 2u; voffB[i] = (unsigned)(Rb * K + C) * 2u; }
    const size_t kstep = (size_t)(BK * 2);
    const size_t hstep = (size_t)HALF * K * 2;
    const size_t tstep = 2 * hstep;
    const unsigned ldsw = (unsigned)wid * 1024u;
    const int aoff = lds_byte(wr * 64 + fr, fq * 8), boff = lds_byte(wc * 32 + fr, fq * 8);
#define PG8_SA(b, h) (((b) * 2 + (h)) * HTB)
#define PG8_SB(b, h) ((4 + (b) * 2 + (h)) * HTB)
#define PG8_STAGE(bufoff, gbase, voff) do { _Pragma("unroll") for (int _i = 0; _i < 2; ++_i) \
        __builtin_amdgcn_global_load_lds((const unsigned*)((const char*)(gbase) + (voff)[_i]), (PG8_LAS unsigned*)(lds + (bufoff) + ldsw + _i * 8192), 16, 0, 0); } while (0)
#define PG8_LDA(dst, b, h) do { _Pragma("unroll") for (int m = 0; m < 4; ++m) _Pragma("unroll") for (int k = 0; k < 2; ++k) dst[m][k] = *(const PG8_LAS bf16x8*)(lds + PG8_SA(b, h) + aoff + m * 2048 + k * 1024); } while (0)
#define PG8_LDB(dst, b, h) do { _Pragma("unroll") for (int n = 0; n < 2; ++n) _Pragma("unroll") for (int k = 0; k < 2; ++k) dst[n][k] = *(const PG8_LAS bf16x8*)(lds + PG8_SB(b, h) + boff + n * 2048 + k * 1024); } while (0)
#define PG8_MMA(ai, bj, At, Bt) do { __builtin_amdgcn_s_setprio(1); _Pragma("unroll") for (int m = 0; m < 4; ++m) _Pragma("unroll") for (int n = 0; n < 2; ++n) _Pragma("unroll") for (int k = 0; k < 2; ++k) \
        acc[ai][bj][m][n] = __builtin_amdgcn_mfma_f32_16x16x32_bf16(Bt[n][k], At[m][k], acc[ai][bj][m][n], 0, 0, 0); __builtin_amdgcn_s_setprio(0); } while (0)
#define PG8_WAIT_V(n) asm volatile("s_waitcnt vmcnt(" #n ")" ::: "memory")
#define PG8_WAIT_L(n) asm volatile("s_waitcnt lgkmcnt(" #n ")" ::: "memory")
#define PG8_BAR __builtin_amdgcn_s_barrier()
#define PG8_SCHED __builtin_amdgcn_sched_barrier(0)
    Unit cur, nxt; int ui = 0;
    if (!S.next(0, cur)) return;
    f32x4 acc[2][2][4][2];
#pragma unroll
    for (int a = 0; a < 2; ++a)
#pragma unroll
        for (int b = 0; b < 2; ++b)
#pragma unroll
            for (int m = 0; m < 4; ++m)
#pragma unroll
                for (int n = 0; n < 2; ++n) acc[a][b][m][n] = (f32x4){0.f, 0.f, 0.f, 0.f};
    bf16x8 At[4][2], B0[2][2], B1[2][2];
    const char* cA = (const char*)g.A + (size_t)cur.pm * tstep; const char* cB = (const char*)g.Bt + (size_t)cur.pn * tstep;
    S.a_ready(cur);
    if constexpr (SP2) {
        PG8_STAGE(PG8_SB(0, 0), cB, voffB); PG8_STAGE(PG8_SB(0, 1), cB + hstep, voffB); PG8_STAGE(PG8_SA(0, 0), cA, voffA); PG8_STAGE(PG8_SA(0, 1), cA + hstep, voffA);
        if (wr == 1) PG8_BAR;
        PG8_WAIT_V(2); PG8_BAR;
        PG8_STAGE(PG8_SB(1, 0), cB + kstep, voffB); PG8_STAGE(PG8_SA(1, 0), cA + kstep, voffA); PG8_STAGE(PG8_SB(1, 1), cB + hstep + kstep, voffB);
        PG8_WAIT_V(6); PG8_BAR;
    } else {
        PG8_STAGE(PG8_SB(0, 0), cB, voffB); PG8_STAGE(PG8_SA(0, 0), cA, voffA); PG8_STAGE(PG8_SB(0, 1), cB + hstep, voffB); PG8_STAGE(PG8_SA(0, 1), cA + hstep, voffA);
        if (wr == 1) PG8_BAR;
        PG8_WAIT_V(4); PG8_BAR;
        PG8_STAGE(PG8_SB(1, 0), cB + kstep, voffB); PG8_STAGE(PG8_SA(1, 0), cA + kstep, voffA); PG8_STAGE(PG8_SB(1, 1), cB + hstep + kstep, voffB);
        PG8_WAIT_V(6); PG8_BAR;
    }
    for (;;) {
        const bool has_next = S.next(ui + 1, nxt);
        const char* nA = has_next ? (const char*)g.A + (size_t)nxt.pm * tstep : cA; const char* nB = has_next ? (const char*)g.Bt + (size_t)nxt.pn * tstep : cB;
        for (int t = 0; t < nt; t += 2) {
            const bool last = (t == nt - 2);
            const char* a1 = cA + (size_t)(t + 1) * kstep;
            const char* a2 = last ? nA : cA + (size_t)(t + 2) * kstep; const char* b2 = last ? nB : cB + (size_t)(t + 2) * kstep;
            const char* a3 = a2 + kstep; const char* b3 = b2 + kstep;
            if (last && has_next) S.a_ready(nxt);
            if constexpr (SP2) {
            PG8_LDB(B0, 0, 0); PG8_LDB(B1, 0, 1); PG8_SCHED; PG8_LDA(At, 0, 0); PG8_STAGE(PG8_SA(1, 1), a1 + hstep, voffA);
            PG8_WAIT_V(8); PG8_WAIT_L(0); PG8_BAR; PG8_MMA(0, 0, At, B0); PG8_MMA(0, 1, At, B1); PG8_BAR; PG8_SCHED;
            PG8_LDA(At, 0, 1); PG8_STAGE(PG8_SB(0, 0), b2, voffB); PG8_STAGE(PG8_SB(0, 1), b2 + hstep, voffB); PG8_STAGE(PG8_SA(0, 0), a2, voffA);
            PG8_WAIT_V(8); PG8_WAIT_L(0); PG8_BAR; PG8_MMA(1, 0, At, B0); PG8_MMA(1, 1, At, B1); PG8_BAR; PG8_SCHED;
            PG8_LDB(B0, 1, 0); PG8_LDB(B1, 1, 1); PG8_SCHED; PG8_LDA(At, 1, 0); PG8_STAGE(PG8_SA(0, 1), a2 + hstep, voffA);
            PG8_WAIT_V(8); PG8_WAIT_L(0); PG8_BAR; PG8_MMA(0, 0, At, B0); PG8_MMA(0, 1, At, B1); PG8_BAR; PG8_SCHED;
            PG8_LDA(At, 1, 1); PG8_STAGE(PG8_SB(1, 0), b3, voffB); PG8_STAGE(PG8_SB(1, 1), b3 + hstep, voffB); PG8_STAGE(PG8_SA(1, 0), a3, voffA);
            PG8_WAIT_V(8); PG8_WAIT_L(0); PG8_BAR; PG8_MMA(1, 0, At, B0); PG8_MMA(1, 1, At, B1); PG8_BAR; PG8_SCHED;
            } else {
            PG8_LDB(B0, 0, 0); PG8_SCHED; PG8_LDA(At, 0, 0); PG8_STAGE(PG8_SA(1, 1), a1 + hstep, voffA);
            PG8_WAIT_L(8); PG8_BAR; PG8_WAIT_L(0); PG8_MMA(0, 0, At, B0); PG8_BAR; PG8_SCHED;
            PG8_LDB(B1, 0, 1); PG8_STAGE(PG8_SB(0, 0), b2, voffB);
            PG8_BAR; PG8_WAIT_L(0); PG8_MMA(0, 1, At, B1); PG8_BAR;
            PG8_LDA(At, 0, 1); PG8_STAGE(PG8_SA(0, 0), a2, voffA);
            PG8_BAR; PG8_WAIT_L(0); PG8_MMA(1, 0, At, B0); PG8_BAR; PG8_SCHED;
            PG8_STAGE(PG8_SB(0, 1), b2 + hstep, voffB);
            PG8_WAIT_V(6); PG8_BAR; PG8_MMA(1, 1, At, B1); PG8_BAR;
            PG8_LDB(B0, 1, 0); PG8_SCHED; PG8_LDA(At, 1, 0); PG8_STAGE(PG8_SA(0, 1), a2 + hstep, voffA);
            PG8_WAIT_L(8); PG8_BAR; PG8_WAIT_L(0); PG8_MMA(0, 0, At, B0); PG8_BAR; PG8_SCHED;
            PG8_LDB(B1, 1, 1); PG8_STAGE(PG8_SB(1, 0), b3, voffB);
            PG8_BAR; PG8_WAIT_L(0); PG8_MMA(0, 1, At, B1); PG8_BAR;
            PG8_LDA(At, 1, 1); PG8_STAGE(PG8_SA(1, 0), a3, voffA);
            PG8_BAR; PG8_WAIT_L(0); PG8_MMA(1, 0, At, B0); PG8_BAR; PG8_SCHED;
            PG8_STAGE(PG8_SB(1, 1), b3 + hstep, voffB);
            PG8_WAIT_V(6); PG8_BAR; PG8_MMA(1, 1, At, B1); PG8_BAR;
            }
        }
        if constexpr (ALIGN_EPI) { if (wr == 0) PG8_BAR; }
        if constexpr (!Epi::AFTER_DRAIN) { E(acc, cur, wr, wc, fr, fq); S.done(cur); }
        if (!has_next) break;
#pragma unroll
        for (int a = 0; a < 2; ++a)
#pragma unroll
            for (int b = 0; b < 2; ++b)
#pragma unroll
                for (int m = 0; m < 4; ++m)
#pragma unroll
                    for (int n = 0; n < 2; ++n) acc[a][b][m][n] = (f32x4){0.f, 0.f, 0.f, 0.f};
        cur = nxt; cA = nA; cB = nB; ++ui;
        if constexpr (ALIGN_EPI) { if (wr == 1) PG8_BAR; }
    }
    PG8_WAIT_V(0);
    if constexpr (!ALIGN_EPI) { if (wr == 0) PG8_BAR; }
    PG8_BAR;
    if constexpr (Epi::AFTER_DRAIN) { E.fused(acc, cur, wr, wc, fr, fq, lds, wid, lane); S.done(cur); }
#undef PG8_SA
#undef PG8_SB
#undef PG8_STAGE
#undef PG8_LDA
#undef PG8_LDB
#undef PG8_MMA
#undef PG8_WAIT_V
#undef PG8_WAIT_L
#undef PG8_BAR
#undef PG8_SCHED
}
}
#define XB_TMO      128
#define XB_XCNT(j)  (256  + 64 * (j))
#define XB_XSUB(j)  (1280 + 64 * (j))
#define XB_XGEN(j)  (2304 + 64 * (j))
#define XB_TOP      3328
#define XB_TOPGEN   3392
#define XCD_BAR_WORDS 3456
#define XB_SPIN_CAP (1u << 18)

__device__ __forceinline__ unsigned xb_ld(unsigned* p)              { return __hip_atomic_load(p, __ATOMIC_RELAXED, __HIP_MEMORY_SCOPE_AGENT); }
__device__ __forceinline__ unsigned xb_add(unsigned* p, unsigned v) { return __hip_atomic_fetch_add(p, v, __ATOMIC_RELAXED, __HIP_MEMORY_SCOPE_AGENT); }
__device__ __forceinline__ unsigned xb_xcc_id() { return (unsigned)__builtin_amdgcn_s_getreg((3 << 11) | 20) & 0xFu; }
#define XB_SPIN(cond, bar) do { unsigned _sp = 0; while (cond) { __builtin_amdgcn_s_sleep(1); \
    if ((++_sp & 255u) == 0u) { if (xb_ld(&(bar)[XB_TMO])) break; if (_sp > XB_SPIN_CAP) { atomicAdd(&(bar)[XB_TMO], 1u); break; } } } } while (0)

struct XcdBarrier {
    unsigned* bar; unsigned x;
    volatile LAS unsigned* st;
};

__device__ __forceinline__ XcdBarrier xcd_barrier_post(unsigned* bar, volatile LAS unsigned* st) {
    XcdBarrier b; b.bar = bar; b.x = xb_xcc_id(); b.st = st;
    if (threadIdx.x == 0) (void)xb_add(&bar[XB_XCNT(b.x)], 1u);
    return b;
}
__device__ __forceinline__ void xcd_barrier_complete(unsigned* bar, unsigned x, unsigned& nloc, unsigned& nx) {
    const unsigned G = gridDim.x * gridDim.y * gridDim.z;
    unsigned sum, cnt, mine, sp = 0u;
    for (;;) {
        sum = 0u; cnt = 0u; mine = 0u;
        unsigned cv[16];
#pragma unroll
        for (unsigned j = 0; j < 16; ++j) cv[j] = xb_ld(&bar[XB_XCNT(j)]);
#pragma unroll
        for (unsigned j = 0; j < 16; ++j) { const unsigned c = cv[j]; sum += c; cnt += (c > 0u) ? 1u : 0u; mine = (j == x) ? c : mine; }
        if (sum == G) break;
        __builtin_amdgcn_s_sleep(1);
        if ((++sp & 255u) == 0u) { if (xb_ld(&bar[XB_TMO])) break; if (sp > XB_SPIN_CAP) { atomicAdd(&bar[XB_TMO], 1u); break; } }
    }
    nloc = mine > 0u ? mine : 1u; nx = cnt > 0u ? cnt : 1u;
}

__device__ __forceinline__ void xcd_barrier(const XcdBarrier& b) {
    asm volatile("s_waitcnt vmcnt(0)" ::: "memory");
    __syncthreads();
    if (threadIdx.x == 0) {
        unsigned* bar = b.bar;
        __builtin_amdgcn_s_waitcnt(0);
        unsigned nloc = b.st[0], nx = b.st[1];
        if (nloc == 0u) { xcd_barrier_complete(bar, b.x, nloc, nx); b.st[0] = nloc; b.st[1] = nx; }
        const unsigned old = xb_add(&bar[XB_XSUB(b.x)], 1u);
        const unsigned gen = old / nloc;
        if (old + 1u == (gen + 1u) * nloc) {
            __builtin_amdgcn_fence(__ATOMIC_RELEASE, "agent");
            asm volatile("s_waitcnt vmcnt(0)" ::: "memory");
            const unsigned og = xb_add(&bar[XB_TOP], 1u);
            const unsigned tg = og / nx;
            if (og + 1u == (tg + 1u) * nx) xb_add(&bar[XB_TOPGEN], 1u);
            else XB_SPIN(xb_ld(&bar[XB_TOPGEN]) == tg, bar);
            __builtin_amdgcn_fence(__ATOMIC_ACQUIRE, "agent");
            xb_add(&bar[XB_XGEN(b.x)], 1u);
            asm volatile("s_waitcnt vmcnt(0)" ::: "memory");
        } else {
            XB_SPIN(xb_ld(&bar[XB_XGEN(b.x)]) == gen, bar);
            __builtin_amdgcn_fence(__ATOMIC_ACQUIRE, "agent");
            asm volatile("s_waitcnt vmcnt(0)" ::: "memory");
        }
    }
    __syncthreads();
}
struct Frame {
    LAS unsigned char* lds;
    volatile LAS unsigned* MISC;
    gu32* ctl;
    unsigned char* ws;
    int tid, lane, wave;
    int vcu, G;
    const CAS cfptr* in;
    float* out;
};
DI unsigned long long* rowsq_ptr(const Frame& F, int v) { return (unsigned long long*)(F.ws + WS_CTL + (size_t)CW_ROWSQ * 4) + (size_t)v * M; }

struct TrItem { const float* W; const float* sc; bf16* dst; int N, Kd, k0, n0, drow0; };
constexpr int I_G = (D / 64) * (DFF / 64);
constexpr int I_IN = (D / 64) * 121;
constexpr int I_OUT = (D / 64) * (D / 64);
constexpr int I_LAYER = 6 * I_G + I_IN + I_OUT;
constexpr int I_TOTAL = DEPTH * I_LAYER;
constexpr int CV_P0 = 2 * I_G;
constexpr int CV_G = 128 * 8 * 7, CV_W = 32 * 8 * 7, CV_M = 232 * 8 * 4, CV_LAYER = 2 * CV_G + CV_W + CV_M;
DI void cv_slot(int l, int j, int& lo, int& hi) {
    const int off = (j == 0) ? 0 : (j == 1) ? CV_G : (j == 2) ? CV_G + CV_W : CV_G + CV_W + CV_M, cap = (j == 0 || j == 3) ? CV_G : (j == 1) ? CV_W : CV_M;
    const int s0 = CV_P0 + l * CV_LAYER + off; lo = s0 < I_TOTAL ? s0 : I_TOTAL; hi = (s0 + cap) < I_TOTAL ? (s0 + cap) : I_TOTAL;
}
DI void tr_decode(const Frame& F, int git, TrItem& t) {
    const int l = git / I_LAYER; int r = git - l * I_LAYER;
    int s = 0;
    if (r >= 3 * I_G + I_IN + I_OUT) { s = 1; r -= 3 * I_G + I_IN + I_OUT; }
    if (r < 3 * I_G) {
        const int kind = r / I_G; r -= kind * I_G; const int f = 2 * l + s;
        if (kind < 2) {
            const int up = kind;
            t.W = F.in[s ? (up ? 21 : 20) : (up ? 3 : 2)] + (size_t)l * D * DFF; t.sc = F.in[s ? 19 : 1] + l * D;
            const int kb = r / (DFF / 64), nb = r % (DFF / 64); t.k0 = 64 * kb; t.n0 = 64 * nb; t.N = DFF; t.Kd = D;
            t.dst = (bf16*)(F.ws + WS_WGU + (size_t)f * SZ_WGU1); t.drow0 = 256 * (t.n0 >> 7) + (t.n0 & 127) + (up ? 128 : 0);
        } else {
            t.W = F.in[s ? 22 : 4] + (size_t)l * DFF * D; t.sc = nullptr;
            const int kb = r / (D / 64), nb = r % (D / 64); t.k0 = 64 * kb; t.n0 = 64 * nb; t.N = D; t.Kd = DFF;
            t.dst = (bf16*)(F.ws + WS_WD + (size_t)f * SZ_WD1); t.drow0 = t.n0;
        }
        return;
    }
    r -= 3 * I_G;
    if (r < I_IN) {
        t.W = F.in[6] + (size_t)l * D * DIN; t.sc = F.in[5] + l * D;
        const int kb = r / 121, nb = r % 121; t.k0 = 64 * kb; t.n0 = 64 * nb; t.N = DIN; t.Kd = D;
        t.dst = (bf16*)(F.ws + WS_WIN + (size_t)l * SZ_WIN1); t.drow0 = t.n0;
        return;
    }
    r -= I_IN;
    {
        t.W = F.in[7] + (size_t)l * D * D; t.sc = nullptr;
        const int kb = r / (D / 64), nb = r % (D / 64); t.k0 = 64 * kb; t.n0 = 64 * nb; t.N = D; t.Kd = D;
        t.dst = (bf16*)(F.ws + WS_WOUT + (size_t)l * SZ_WOUT1); t.drow0 = t.n0;
    }
}
DI void tr_load(const TrItem& t, int lane, f32x4 (&v)[16], f32x4 (&sc)[2], int variant = 0) {
    sc[0] = (f32x4){1.f, 1.f, 1.f, 1.f}; sc[1] = sc[0];
    if (t.sc) { sc[0] = *(const GAS f32x4*)(t.sc + t.k0 + 8 * (lane & 7)); sc[1] = *(const GAS f32x4*)(t.sc + t.k0 + 8 * (lane & 7) + 4); }
    if (variant & 2) {
#pragma unroll
        for (int i = 0; i < 16; ++i) v[i] = (f32x4){1.f, 2.f, 3.f, 4.f};
        return; }
    const int n = t.n0 + 4 * (lane & 15); const bool ok = n < t.N;
    const float* p = t.W + (size_t)(t.k0 + (lane >> 4)) * t.N + n;
#pragma unroll
    for (int i = 0; i < 16; ++i) v[i] = ok ? __builtin_nontemporal_load((const GAS f32x4*)(p + (size_t)(4 * i) * t.N)) : (f32x4){0.f, 0.f, 0.f, 0.f};
}
DI void tr_store(const TrItem& t, int lane, const f32x4 (&v)[16], const f32x4 (&sc)[2], LAS float* scr, int variant = 0) {
    if (variant & 1) {
        const int c = lane & 7;
#pragma unroll
        for (int j = 0; j < 8; ++j) { const int nn = (lane >> 3) + 8 * j; v4u o; o.x = pk2(v[2 * j].x, v[2 * j].y); o.y = pk2(v[2 * j].z, v[2 * j].w); o.z = pk2(v[2 * j + 1].x, v[2 * j + 1].y); o.w = pk2(v[2 * j + 1].z, v[2 * j + 1].w);
            *(GAS v4u*)(t.dst + (size_t)(t.drow0 + nn) * t.Kd + t.k0 + 8 * c) = o; }
        return;
    }
    {
        LAS float* w = scr + (lane >> 4) * 65 + 4 * (lane & 15);
#pragma unroll
        for (int i = 0; i < 16; ++i) { w[(4 * i) * 65 + 0] = v[i].x; w[(4 * i) * 65 + 1] = v[i].y; w[(4 * i) * 65 + 2] = v[i].z; w[(4 * i) * 65 + 3] = v[i].w; }
    }
    LDS_WAIT(); asm volatile("" ::: "memory");
    const int c = lane & 7;
    const f32x4 s0 = sc[0], s1 = sc[1];
#pragma unroll
    for (int j = 0; j < 8; ++j) {
        const int nn = (lane >> 3) + 8 * j; const LAS float* s = scr + (8 * c) * 65 + nn;
        v4u o; o.x = pk2(s[0 * 65] * s0.x, s[1 * 65] * s0.y); o.y = pk2(s[2 * 65] * s0.z, s[3 * 65] * s0.w); o.z = pk2(s[4 * 65] * s1.x, s[5 * 65] * s1.y); o.w = pk2(s[6 * 65] * s1.z, s[7 * 65] * s1.w);
        if (!(variant & 4)) *(GAS v4u*)(t.dst + (size_t)(t.drow0 + nn) * t.Kd + t.k0 + 8 * c) = o;
        else asm volatile("" :: "v"(o));
    }
    LDS_WAIT(); asm volatile("" ::: "memory");
}
DI void sincos_d(double x, double& s, double& c) {
    const double x2 = x * x;
    double ps = 0.0, pc = 0.0;
    double ts = 1.0, tc = 1.0;
    double ss = 0.0, cc = 0.0;
#pragma unroll
    for (int k = 0; k < 15; ++k) {
        ss += ts; cc += tc;
        ts = -ts * x2 / (double)((2 * k + 2) * (2 * k + 3));
        tc = -tc * x2 / (double)((2 * k + 1) * (2 * k + 2));
    }
    (void)ps; (void)pc;
    s = ss * x; c = cc;
}
DI void convert_range(const Frame& F, int lo, int hi, int wi, int wn, LAS float* scr, int variant = 0) {
    TrItem cur, nxt; f32x4 va[16], vb[16], sa[2], sb[2];
    int it = lo + wi;
    if (it < hi) { tr_decode(F, it, cur); tr_load(cur, F.lane, va, sa, variant); }
#pragma unroll 1
    for (; it < hi; it += 2 * wn) {
        const bool h1 = it + wn < hi;
        if (h1) { tr_decode(F, it + wn, nxt); tr_load(nxt, F.lane, vb, sb, variant); }
        __builtin_amdgcn_sched_barrier(0);
        tr_store(cur, F.lane, va, sa, scr, variant);
        if (!h1) break;
        const bool h2 = it + 2 * wn < hi;
        if (h2) { tr_decode(F, it + 2 * wn, cur); tr_load(cur, F.lane, va, sa, variant); }
        __builtin_amdgcn_sched_barrier(0);
        tr_store(nxt, F.lane, vb, sb, scr, variant);
        if (!h2) break;
    }
}
DI void p0_prologue(Frame& F, int variant = 0) {
    LAS float* scr = (LAS float*)(F.lds + F.wave * 16896);
    const bool split = (F.G == 256);
    const bool conv_role = !split || ((blockIdx.x & 1) == 0), misc_role = !split || ((blockIdx.x & 1) == 1);
    const int rk = split ? (int)(blockIdx.x >> 1) : F.vcu, nrk = split ? 128 : F.G;
    const int gw = rk * 8 + F.wave, NGW = nrk * 8;
    if (conv_role) convert_range(F, 0, split ? CV_P0 : I_TOTAL, gw, NGW, scr, variant);
    if (!misc_role) return;
    {
        const size_t per = (size_t)(DINP - 7744) * D * 2 / 16;
        const size_t gt = (size_t)(rk * 512 + F.tid), NT = (size_t)nrk * 512;
        for (size_t i = gt; i < per * DEPTH; i += NT) { const size_t l = i / per, o = i % per;
            *(GAS v4u*)(F.ws + WS_WIN + l * SZ_WIN1 + (size_t)7744 * D * 2 + o * 16) = (v4u){0u, 0u, 0u, 0u}; }
    }
    {
        const float* x = F.in[0]; bf16* xb = (bf16*)(F.ws + WS_XB); unsigned char* xl = F.ws + WS_XLO; unsigned long long* rq = rowsq_ptr(F, 0);
        for (int m = gw; m < M; m += NGW) {
            const GAS f32x4* xr = (const GAS f32x4*)(x + (size_t)m * D) + F.lane; GAS v2u* o = (GAS v2u*)(xb + (size_t)m * D) + F.lane; float s = 0.f;
            f32x4 vv[8];
#pragma unroll
            for (int j = 0; j < 8; ++j) vv[j] = xr[64 * j];
#pragma unroll
            for (int j = 0; j < 8; ++j) {
                const f32x4 v = vv[j]; s += (v.x * v.x + v.y * v.y) + (v.z * v.z + v.w * v.w);
                const unsigned b0 = __float_as_uint(v.x), b1 = __float_as_uint(v.y), b2 = __float_as_uint(v.z), b3 = __float_as_uint(v.w);
                v2u w; w.x = ((b0 + 0x8000u) >> 16) | ((b1 + 0x8000u) & 0xffff0000u); w.y = ((b2 + 0x8000u) >> 16) | ((b3 + 0x8000u) & 0xffff0000u); o[64 * j] = w;
                const int c = 256 * j + 4 * F.lane, cl = c & 255, bj = cl >> 7, wc = (cl & 127) >> 5, fq = (cl & 31) >> 3, k = cl & 7;
                *(GAS unsigned*)(xl + (size_t)m * D + (c & ~255) + ((wc * 4 + fq) * 2 + bj) * 8 + k) = ((b0 >> 8) & 0xffu) | (b1 & 0xff00u) | ((b2 << 8) & 0xff0000u) | ((b3 << 16) & 0xff000000u);
            }
            s = wave_sum(s); if (F.lane == 0) rq[m] = (unsigned long long)(s * 16777216.0f + 0.5f);
        }
    }
    {
        f32x2* tab = (f32x2*)(F.ws + WS_ROPE);
        const int gt = rk * 512 + F.tid, NT = nrk * 512;
        for (int e = gt; e < SEQ * 32; e += NT) {
            const int t = e >> 5, i = e & 31;
            const double w = exp2(-(double)i * (13.287712379549449 / 32.0));
            double rev = (double)t * w * 0.15915494309189535; rev -= rint(rev);
            double s, c; sincos_d(rev * 6.283185307179586, s, c);
            tab[e] = (f32x2){(float)c, (float)s};
        }
    }
    {
        float* lbs = (float*)(F.ws + WS_LBS); const float* p = F.in[13];
        const int gt = rk * 512 + F.tid;
        if (gt < 768) {
            float v0 = p[gt], v1 = p[768 + gt], v2 = p[1536 + gt], v3 = p[2304 + gt];
            const float mx = fmaxf(fmaxf(v0, v1), fmaxf(v2, v3));
            v0 = fexp(v0 - mx); v1 = fexp(v1 - mx); v2 = fexp(v2 - mx); v3 = fexp(v3 - mx);
            const float inv = 1.f / (v0 + v1 + v2 + v3);
            lbs[gt] = 0.f; lbs[768 + gt] = v1 * inv; lbs[1536 + gt] = (v1 + v2) * inv; lbs[2304 + gt] = (v1 + v2 + v3) * inv;
        }
        if (gt >= 1024 && gt < 1024 + DEPTH) {
            const int l = gt - 1024; float a = 0.f, b = 0.f;
            for (int i = 0; i < 64; ++i) { a += F.in[8][l * 64 + i] * F.in[9][l * 64 + i]; b += F.in[10][l * 64 + i] * F.in[11][l * 64 + i]; }
            const float li = 0.8f - 0.6f * expf(-0.3f * (float)l);
            float* lam = (float*)(F.ws + WS_LBS + 16384);
            lam[2 * l] = expf(a) - expf(b) + li; lam[2 * l + 1] = li;
        }
    }
}
DI void attn_prep_job(const Frame& F, int job) {
    const int bh = job >> 6, tile = job & 63, b = bh >> 2, h = bh & 3;
    const bf16* P = (const bf16*)(F.ws + WS_P);
    const f32x2* rope = (const f32x2*)(F.ws + WS_ROPE);
    const int tid = F.tid;
    {
        const int kk = tid >> 3, c = (tid >> 2) & 1, dg = tid & 3, t = tile * 64 + kk; const size_t m = (size_t)b * SEQ + t;
        float cs[8], sn[8];
#pragma unroll
        for (int i = 0; i < 8; ++i) { const f32x2 v = rope[t * 32 + 8 * dg + i]; cs[i] = v.x; sn[i] = v.y; }
        v4u la[2], lb[2];
#pragma unroll
        for (int isk = 0; isk < 2; ++isk) { const bf16* src = P + m * NP + (isk ? PA_K : PA_Q) + h * 128 + c * 64 + 8 * dg; la[isk] = *(const GAS v4u*)src; lb[isk] = *(const GAS v4u*)(src + 32); }
#pragma unroll
        for (int isk = 0; isk < 2; ++isk) {
            const v4u a = la[isk], bb = lb[isk];
            float x1[8], x2[8];
            x1[0] = bflo(a.x); x1[1] = bfhi(a.x); x1[2] = bflo(a.y); x1[3] = bfhi(a.y); x1[4] = bflo(a.z); x1[5] = bfhi(a.z); x1[6] = bflo(a.w); x1[7] = bfhi(a.w);
            x2[0] = bflo(bb.x); x2[1] = bfhi(bb.x); x2[2] = bflo(bb.y); x2[3] = bfhi(bb.y); x2[4] = bflo(bb.z); x2[5] = bfhi(bb.z); x2[6] = bflo(bb.w); x2[7] = bfhi(bb.w);
            const float sc = isk ? 1.0f : 0.125f * 1.4426950408889634f;
            float o1[8], o2[8];
#pragma unroll
            for (int i = 0; i < 8; ++i) { o1[i] = (x1[i] * cs[i] - x2[i] * sn[i]) * sc; o2[i] = (x2[i] * cs[i] + x1[i] * sn[i]) * sc; }
            v4u w1, w2; w1.x = pk2(o1[0], o1[1]); w1.y = pk2(o1[2], o1[3]); w1.z = pk2(o1[4], o1[5]); w1.w = pk2(o1[6], o1[7]);
            w2.x = pk2(o2[0], o2[1]); w2.y = pk2(o2[2], o2[3]); w2.z = pk2(o2[4], o2[5]); w2.w = pk2(o2[6], o2[7]);
            if (!isk) {
                bf16* q = (bf16*)(F.ws + WS_QR) + (((size_t)bh * 2 + c) * SEQ + t) * 64 + 8 * dg;
                *(GAS v4u*)q = w1; *(GAS v4u*)(q + 32) = w2;
            } else {
                unsigned char* kf = F.ws + WS_KF + (((size_t)bh * 2 + c) * 64 + tile) * 8192;
                const int kvb = kk >> 5, r32 = kk & 31;
                const int d1 = 8 * dg, d2 = 32 + 8 * dg;
                *(GAS v4u*)(kf + ((kvb * 4 + (d1 >> 4)) * 64 + r32 + 32 * ((d1 >> 3) & 1)) * 16) = w1;
                *(GAS v4u*)(kf + ((kvb * 4 + (d2 >> 4)) * 64 + r32 + 32 * ((d2 >> 3) & 1)) * 16) = w2;
            }
        }
    }
    {
        unsigned char* vf = F.ws + WS_VF + ((size_t)bh * 64 + tile) * 16384;
        unsigned short ev[2][8];
#pragma unroll
        for (int rep = 0; rep < 2; ++rep) {
            const int task = tid + 512 * rep, dv = task & 127, grp = task >> 7, kb = grp >> 2, s = (grp >> 1) & 1, hh = grp & 1;
            const GAS bf16* src = (const GAS bf16*)(P + ((size_t)b * SEQ + tile * 64 + 32 * kb + 16 * s + 4 * hh) * NP + PA_V + h * 128 + dv);
#pragma unroll
            for (int j = 0; j < 8; ++j) ev[rep][j] = src[(size_t)(8 * (j >> 2) + (j & 3)) * NP];
        }
#pragma unroll
        for (int rep = 0; rep < 2; ++rep) {
            const int task = tid + 512 * rep, dv = task & 127, grp = task >> 7, kb = grp >> 2, s = (grp >> 1) & 1, hh = grp & 1;
            const unsigned short* e = ev[rep];
            v4u w; w.x = e[0] | ((unsigned)e[1] << 16); w.y = e[2] | ((unsigned)e[3] << 16); w.z = e[4] | ((unsigned)e[5] << 16); w.w = e[6] | ((unsigned)e[7] << 16);
            *(GAS v4u*)(vf + ((((dv >> 5) * 2 + kb) * 2 + s) * 64 + (dv & 31) + 32 * hh) * 16) = w;
        }
    }
}

DI void hgrn_prep_job(const Frame& F, int job, int layer, LAS unsigned char* scr) {
    const int bh = job >> 7, ch = job & 127, b = bh / 6, h = bh % 6, lane = F.lane;
    const bf16* P = (const bf16*)(F.ws + WS_P);
    const size_t m0 = (size_t)b * SEQ + ch * 32;
    const float* lbs = (const float*)(F.ws + WS_LBS) + layer * 768 + h * 128;
    LAS unsigned char* QL = scr; LAS unsigned char* KL = scr + 8704;
    unsigned char* hq = F.ws + WS_HQ + ((size_t)bh * 128 + ch) * 8192;
    unsigned char* hk = F.ws + WS_HK + ((size_t)bh * 128 + ch) * 8192;
    unsigned char* hv = F.ws + WS_HV + ((size_t)bh * 128 + ch) * 8192;
    unsigned char* ha = F.ws + WS_HA + ((size_t)bh * 128 + ch) * 2048;
    float* he = (float*)(F.ws + WS_HE + ((size_t)bh * 128 + ch) * 512);
#pragma unroll 1
    for (int half = 0; half < 2; ++half) {
        const int dk = 64 * half + lane;
        const float lb = ((const GAS float*)lbs)[dk];
        const GAS bf16* pq = (const GAS bf16*)(P + m0 * NP + PB_Q + h * 128 + dk); const GAS bf16* pf = (const GAS bf16*)(P + m0 * NP + PB_F + h * 128 + dk); const GAS bf16* pv = (const GAS bf16*)(P + m0 * NP + PB_I + h * 128 + dk);
        unsigned short ve[32];
#pragma unroll
        for (int t = 0; t < 32; ++t) ve[t] = pv[(size_t)t * NP];
        float bq[32], kv[32], qv[32]; float bsum = 0.f;
        unsigned short qe[32], fe[32];
#pragma unroll
        for (int t = 0; t < 32; ++t) { qe[t] = pq[(size_t)t * NP]; fe[t] = pf[(size_t)t * NP]; }
#pragma unroll
        for (int t = 0; t < 32; ++t) {
            const float qx = bf2f(qe[t]), fx = bf2f(fe[t]);
            const float f = lb + (1.f - lb) * sigm(fx);
            bsum += flog(f); bq[t] = bsum; kv[t] = 1.f - f; qv[t] = silu(qx);
        }
        ((GAS float*)he)[dk] = fexp(bsum);
#pragma unroll
        for (int t = 0; t < 32; ++t) {
            const float e = fexp(bq[t]);
            *(LAS bf16*)(QL + t * 272 + dk * 2) = (bf16)(pk2(qv[t] * e, 0.f) & 0xffffu);
            *(LAS bf16*)(KL + t * 272 + dk * 2) = (bf16)(pk2(kv[t] * frcp(e), 0.f) & 0xffffu);
            kv[t] = kv[t] * fexp(bsum - bq[t]);
        }
#pragma unroll
        for (int g = 0; g < 4; ++g) {
            v4u w; w.x = pk2(kv[permk(g, 0)], kv[permk(g, 1)]); w.y = pk2(kv[permk(g, 2)], kv[permk(g, 3)]); w.z = pk2(kv[permk(g, 4)], kv[permk(g, 5)]); w.w = pk2(kv[permk(g, 6)], kv[permk(g, 7)]);
            *(GAS v4u*)(hk + (((dk >> 4) * 64) + (dk & 15) + 16 * g) * 16) = w;
        }
#pragma unroll
        for (int g = 0; g < 4; ++g) {
            v4u w; w.x = ve[permk(g, 0)] | ((unsigned)ve[permk(g, 1)] << 16); w.y = ve[permk(g, 2)] | ((unsigned)ve[permk(g, 3)] << 16);
            w.z = ve[permk(g, 4)] | ((unsigned)ve[permk(g, 5)] << 16); w.w = ve[permk(g, 6)] | ((unsigned)ve[permk(g, 7)] << 16);
            *(GAS v4u*)(hv + (((dk >> 4) * 64) + (dk & 15) + 16 * g) * 16) = w;
        }
    }
    LDS_WAIT(); asm volatile("" ::: "memory");
    const int r = lane & 15, g = lane >> 4;
#pragma unroll
    for (int mt = 0; mt < 2; ++mt)
#pragma unroll
        for (int kb = 0; kb < 4; ++kb) {
            const LAS unsigned char* p = QL + (16 * mt + r) * 272 + (32 * kb + 4 * g) * 2;
            const v2u lo = *(const LAS v2u*)p, hi = *(const LAS v2u*)(p + 32);
            *(GAS v4u*)(hq + ((mt * 4 + kb) * 64 + lane) * 16) = (v4u){lo.x, lo.y, hi.x, hi.y};
        }
    f32x4 acc[2][2];
#pragma unroll
    for (int mt = 0; mt < 2; ++mt)
#pragma unroll
        for (int nt = 0; nt < 2; ++nt) acc[mt][nt] = (f32x4){0.f, 0.f, 0.f, 0.f};
#pragma unroll
    for (int ks = 0; ks < 4; ++ks) {
        bf16x8 af[2], bfr[2];
#pragma unroll
        for (int mt = 0; mt < 2; ++mt) { af[mt] = *(const LAS bf16x8*)(QL + (16 * mt + r) * 272 + (32 * ks + 8 * g) * 2); bfr[mt] = *(const LAS bf16x8*)(KL + (16 * mt + r) * 272 + (32 * ks + 8 * g) * 2); }
#pragma unroll
        for (int mt = 0; mt < 2; ++mt)
#pragma unroll
            for (int nt = 0; nt < 2; ++nt) acc[mt][nt] = __builtin_amdgcn_mfma_f32_16x16x32_bf16(af[mt], bfr[nt], acc[mt][nt], 0, 0, 0);
    }
    LDS_WAIT(); asm volatile("" ::: "memory");
#pragma unroll
    for (int mt = 0; mt < 2; ++mt)
#pragma unroll
        for (int nt = 0; nt < 2; ++nt)
#pragma unroll
            for (int i = 0; i < 4; ++i) { const int t = 16 * mt + 4 * g + i, s = 16 * nt + r;
                *(LAS bf16*)(KL + t * 80 + s * 2) = (bf16)(pk2(s <= t ? acc[mt][nt][i] : 0.f, 0.f) & 0xffffu); }
    LDS_WAIT(); asm volatile("" ::: "memory");
#pragma unroll
    for (int mt = 0; mt < 2; ++mt) {
        const LAS unsigned char* p = KL + (16 * mt + r) * 80 + (4 * g) * 2;
        const v2u lo = *(const LAS v2u*)p, hi = *(const LAS v2u*)(p + 32);
        *(GAS v4u*)(ha + (mt * 64 + lane) * 16) = (v4u){lo.x, lo.y, hi.x, hi.y};
    }
    LDS_WAIT(); asm volatile("" ::: "memory");
}

DI void gate_pass(const Frame& F, int layer) {
    const bf16* P = (const bf16*)(F.ws + WS_P); bf16* GZ = (bf16*)(F.ws + WS_GZ);
    constexpr int NIT = 12 * SEQ * 8;
    int tid = F.tid; asm volatile("" : "+v"(tid));
    const int stride = F.G * 512;
#pragma unroll 1
    for (int i0 = (int)blockIdx.x * 512 + tid; i0 < NIT; i0 += 3 * stride) {
        v4u z[3][2]; f32x4 gn[3][4];
#pragma unroll
        for (int j = 0; j < 3; ++j) {
            const int idx = i0 + j * stride;
            if (idx < NIT) {
                const int rowid = idx >> 3, cg = idx & 7, bh = rowid / SEQ, t = rowid - bh * SEQ, b = bh / 6, h = bh - 6 * b;
                const bf16* src = P + ((size_t)b * SEQ + t) * NP + PC_Z + h * 128 + 16 * cg;
                const float* gp = F.in[18] + layer * 128 + 16 * cg;
                z[j][0] = *(const GAS v4u*)src; z[j][1] = *(const GAS v4u*)(src + 8);
#pragma unroll
                for (int q = 0; q < 4; ++q) gn[j][q] = *(const GAS f32x4*)(gp + 4 * q);
            }
        }
        __builtin_amdgcn_sched_barrier(0);
#pragma unroll
        for (int j = 0; j < 3; ++j) {
            const int idx = i0 + j * stride;
            if (idx < NIT) {
#pragma unroll
                for (int hlf = 0; hlf < 2; ++hlf) {
                    const v4u zz = z[j][hlf]; const f32x4 ga = gn[j][2 * hlf], gb = gn[j][2 * hlf + 1];
                    v4u o;
                    o.x = pk2(silu(bflo(zz.x)) * ga.x, silu(bfhi(zz.x)) * ga.y); o.y = pk2(silu(bflo(zz.y)) * ga.z, silu(bfhi(zz.y)) * ga.w);
                    o.z = pk2(silu(bflo(zz.z)) * gb.x, silu(bfhi(zz.z)) * gb.y); o.w = pk2(silu(bflo(zz.w)) * gb.z, silu(bfhi(zz.w)) * gb.w);
                    *(GAS v4u*)(GZ + (size_t)idx * 16 + 8 * hlf) = o;
                }
            }
        }
    }
}
namespace gp {
constexpr int KT = 0, QT = 17408, KBT = 34816, VBT = 53248, K2T = 71680, LM = 90112, TM = 107520, AT = 116736, SM = 125952, TF = 126976, XS = 144384, CW = 153088;
}
DI void gdn_prep_job(const Frame& F, int job, int layer, int variant = 0) {
    const int bh = job >> 6, ch = job & 63, b = bh / 6, h = bh % 6, tid = F.tid, lane = F.lane, wave = F.wave;
    const int t0 = ch * 64; const size_t m0 = (size_t)b * SEQ + t0;
    LAS unsigned char* L = F.lds;
    const bf16* P = (const bf16*)(F.ws + WS_P);
    const float* PBA = (const float*)(F.ws + WS_PBA);
    LAS float* BETA = (LAS float*)(L + gp::SM); LAS float* BC = BETA + 64;
    const size_t cidx = (size_t)bh * 64 + ch;
    if (tid < 384) { const int j = tid / 96, i96 = tid % 96, seg = i96 >> 5, c4 = (i96 & 31) * 4;
        const f32x4 cwv = *(const GAS f32x4*)(F.in[15] + ((size_t)layer * 4 + j) * 2304 + seg * 768 + h * 128 + c4);
        *(LAS f32x4*)(L + gp::CW + (j * 384 + seg * 128 + c4) * 4) = cwv; }
    if (wave == 0) {
        const float* pba = PBA + (m0 + lane) * 16;
        const float beta = sigm(pba[h]);
        float g = -fexp(F.in[16][layer * 6 + h]) * softplus(pba[6 + h] + F.in[17][layer * 6 + h]);
#pragma unroll
        for (int o = 1; o < 64; o <<= 1) { const float v = __shfl_up(g, o); if (lane >= o) g += v; }
        const float blast = __shfl(g, 63);
        BETA[lane] = beta; BC[lane] = g;
        if (lane == 0) { BC[64] = blast; ((float*)(F.ws + WS_GE))[cidx] = fexp(blast); }
    }
    LDS_WAIT(); __syncthreads();
    const float blast = BC[64];
        const int t2 = tid >> 3, c02 = 16 * (tid & 7);
        const int pcol2 = PC_V + h * 128 + c02, wch2 = 1536 + h * 128 + c02;
        float av[16];
#pragma unroll
        for (int c = 0; c < 16; ++c) av[c] = 0.f;
        v4u xv[4][2];
#pragma unroll
        for (int j = 0; j < 4; ++j) {
            const int tt = t0 + t2 - 3 + j;
            if (tt >= 0) { const bf16* src = P + ((size_t)b * SEQ + tt) * NP + pcol2; xv[j][0] = *(const GAS v4u*)src; xv[j][1] = *(const GAS v4u*)(src + 8); }
        }
#pragma unroll
        for (int j = 0; j < 4; ++j) {
            const int tt = t0 + t2 - 3 + j;
            if (tt >= 0) {
                const LAS float* wp = (const LAS float*)(L + gp::CW) + j * 384 + 256 + c02;
#pragma unroll
                for (int q4 = 0; q4 < 2; ++q4) {
                    const v4u x = xv[j][q4]; const f32x4 w0 = *(const LAS f32x4*)(wp + 8 * q4), w1 = *(const LAS f32x4*)(wp + 8 * q4 + 4);
                    av[8 * q4 + 0] += bflo(x.x) * w0.x; av[8 * q4 + 1] += bfhi(x.x) * w0.y; av[8 * q4 + 2] += bflo(x.y) * w0.z; av[8 * q4 + 3] += bfhi(x.y) * w0.w;
                    av[8 * q4 + 4] += bflo(x.z) * w1.x; av[8 * q4 + 5] += bfhi(x.z) * w1.y; av[8 * q4 + 6] += bflo(x.w) * w1.z; av[8 * q4 + 7] += bfhi(x.w) * w1.w;
                }
            }
        }
    if (!(variant & 2)) {
        const int t = tid >> 3, isk = (tid >> 2) & 1, part = tid & 3, c0 = 32 * part;
        const int pcol = (isk ? PC_K : PC_Q) + h * 128 + c0, wch = (isk ? 768 : 0) + h * 128 + c0;
        float a[32];
#pragma unroll
        for (int c = 0; c < 32; ++c) a[c] = 0.f;
        v4u xq[4][4];
#pragma unroll
        for (int j = 0; j < 4; ++j) {
            const int tt = t0 + t - 3 + j;
            if (tt >= 0) { const bf16* src = P + ((size_t)b * SEQ + tt) * NP + pcol;
#pragma unroll
                for (int q4 = 0; q4 < 4; ++q4) xq[j][q4] = *(const GAS v4u*)(src + 8 * q4); }
        }
#pragma unroll
        for (int j = 0; j < 4; ++j) {
            const int tt = t0 + t - 3 + j;
            if (tt >= 0) {
                const LAS float* wp = (const LAS float*)(L + gp::CW) + j * 384 + isk * 128 + c0;
#pragma unroll
                for (int q4 = 0; q4 < 4; ++q4) {
                    const v4u x = xq[j][q4]; const f32x4 w0 = *(const LAS f32x4*)(wp + 8 * q4), w1 = *(const LAS f32x4*)(wp + 8 * q4 + 4);
                    a[8 * q4 + 0] += bflo(x.x) * w0.x; a[8 * q4 + 1] += bfhi(x.x) * w0.y; a[8 * q4 + 2] += bflo(x.y) * w0.z; a[8 * q4 + 3] += bfhi(x.y) * w0.w;
                    a[8 * q4 + 4] += bflo(x.z) * w1.x; a[8 * q4 + 5] += bfhi(x.z) * w1.y; a[8 * q4 + 6] += bflo(x.w) * w1.z; a[8 * q4 + 7] += bfhi(x.w) * w1.w;
                }
            }
        }
        float ss = 0.f;
#pragma unroll
        for (int c = 0; c < 32; ++c) { a[c] = silu(a[c]); ss += a[c] * a[c]; }
        ss += __shfl_xor(ss, 1); ss += __shfl_xor(ss, 2);
        const float rinv = frsq(ss + 1e-6f);
        const float bct = BC[t], ebc = fexp(bct);
        if (!isk) {
            const float sc = rinv * 0.08838834764831845f;
#pragma unroll
            for (int c = 0; c < 32; ++c) a[c] *= sc;
#pragma unroll
            for (int q4 = 0; q4 < 4; ++q4) { v4u w; w.x = pk2(a[8 * q4], a[8 * q4 + 1]); w.y = pk2(a[8 * q4 + 2], a[8 * q4 + 3]); w.z = pk2(a[8 * q4 + 4], a[8 * q4 + 5]); w.w = pk2(a[8 * q4 + 6], a[8 * q4 + 7]);
                *(LAS v4u*)(L + gp::QT + t * 272 + (c0 + 8 * q4) * 2) = w; }
            unsigned char* gq = F.ws + WS_GQ + cidx * 16384 + (size_t)(((t >> 4) * 4 + part) * 64 + (t & 15)) * 16;
#pragma unroll
            for (int g = 0; g < 4; ++g) { v4u w; w.x = pk2(a[permk(g, 0)] * ebc, a[permk(g, 1)] * ebc); w.y = pk2(a[permk(g, 2)] * ebc, a[permk(g, 3)] * ebc);
                w.z = pk2(a[permk(g, 4)] * ebc, a[permk(g, 5)] * ebc); w.w = pk2(a[permk(g, 6)] * ebc, a[permk(g, 7)] * ebc);
                *(GAS v4u*)(gq + g * 256) = w; }
        } else {
#pragma unroll
            for (int c = 0; c < 32; ++c) a[c] *= rinv;
#pragma unroll
            for (int q4 = 0; q4 < 4; ++q4) { v4u w; w.x = pk2(a[8 * q4], a[8 * q4 + 1]); w.y = pk2(a[8 * q4 + 2], a[8 * q4 + 3]); w.z = pk2(a[8 * q4 + 4], a[8 * q4 + 5]); w.w = pk2(a[8 * q4 + 6], a[8 * q4 + 7]);
                *(LAS v4u*)(L + gp::KT + t * 272 + (c0 + 8 * q4) * 2) = w; }
            const float s1 = BETA[t] * ebc, s2 = fexp(blast - bct);
#pragma unroll
            for (int c = 0; c < 32; ++c) {
                *(LAS bf16*)(L + gp::KBT + (c0 + c) * 144 + t * 2) = (bf16)(pk2(a[c] * s1, 0.f) & 0xffffu);
                *(LAS bf16*)(L + gp::K2T + (c0 + c) * 144 + t * 2) = (bf16)(pk2(a[c] * s2, 0.f) & 0xffffu);
            }
        }
    }
    {
        const float bt = BETA[t2];
#pragma unroll
        for (int c = 0; c < 16; ++c) *(LAS bf16*)(L + gp::VBT + (c02 + c) * 144 + t2 * 2) = (bf16)(pk2(silu(av[c]) * bt, 0.f) & 0xffffu);
    }
    LDS_WAIT(); __syncthreads();
    const int r = lane & 15, g = lane >> 4;
#pragma unroll 1
    for (int idx = 0; idx < 4; ++idx) {
        const int jb = 4 * wave + idx, type = jb >> 4, ti = (jb >> 2) & 3, tj = jb & 3;
        if (tj > ti) {
            if (type == 1) {
#pragma unroll
                for (int e = 0; e < 4; ++e) *(LAS bf16*)(L + gp::AT + (16 * ti + 4 * g + e) * 144 + (16 * tj + r) * 2) = (bf16)0;
            }
            continue;
        }
        f32x4 acc = {0.f, 0.f, 0.f, 0.f};
        const LAS unsigned char* pa = L + (type ? gp::QT : gp::KT) + (16 * ti + r) * 272 + 16 * g;
        const LAS unsigned char* pb = L + gp::KT + (16 * tj + r) * 272 + 16 * g;
#pragma unroll
        for (int ks = 0; ks < 4; ++ks) acc = __builtin_amdgcn_mfma_f32_16x16x32_bf16(*(const LAS bf16x8*)(pa + 64 * ks), *(const LAS bf16x8*)(pb + 64 * ks), acc, 0, 0, 0);
        const int j = 16 * tj + r; const float bcj = BC[j];
#pragma unroll
        for (int e = 0; e < 4; ++e) {
            const int i = 16 * ti + 4 * g + e; const float dec = fexp(BC[i] - bcj);
            if (type == 0) ((LAS float*)(L + gp::LM))[i * 68 + j] = (i > j) ? BETA[i] * acc[e] * dec : 0.f;
            else *(LAS bf16*)(L + gp::AT + i * 144 + j * 2) = (bf16)(pk2((i >= j) ? acc[e] * dec : 0.f, 0.f) & 0xffffu);
        }
    }
    LDS_WAIT(); __syncthreads();
    {
        LAS float* LMp = (LAS float*)(L + gp::LM); LAS float* TF = (LAS float*)(L + gp::TF); LAS float* XS = (LAS float*)(L + gp::XS) + wave * 272;
        if (wave == 0 && !(variant & 1)) {
            const int bk = lane >> 4, c = lane & 15; const float fc = (float)c;
            float t[16];
#pragma unroll
            for (int i = 0; i < 16; ++i) {
                float acc = fmaxf(0.f, 1.f - fabsf(fc - (float)i));
#pragma unroll
                for (int jj = 0; jj < (i + 3) / 4; ++jj) {
                    const f32x4 l4 = *(const LAS f32x4*)(LMp + (16 * bk + i) * 68 + 16 * bk + 4 * jj);
#pragma unroll
                    for (int e = 0; e < 4; ++e) if (4 * jj + e < i) acc -= l4[e] * t[4 * jj + e];
                }
                t[i] = acc;
                TF[(16 * bk + i) * 68 + 16 * bk + c] = acc;
            }
        } else if (wave != 0) {
            unsigned char* gk = F.ws + WS_GK + cidx * 16384; unsigned char* ga = F.ws + WS_GA + cidx * 8192;
            for (int task = tid - 64; task < 1536; task += 448) {
                const bool isa = task >= 1024; const int t2 = isa ? task - 1024 : task, blk = t2 >> 6, ln = t2 & 63, rr = ln & 15, gg = ln >> 4, mt = blk >> 1, kb = blk & 1;
                const LAS unsigned char* p = L + (isa ? gp::AT : gp::K2T) + (16 * mt + rr) * 144 + (32 * kb + 4 * gg) * 2;
                const v2u lo = *(const LAS v2u*)p, hi = *(const LAS v2u*)(p + 32);
                *(GAS v4u*)((isa ? ga : gk) + (size_t)(blk * 64 + ln) * 16) = (v4u){lo.x, lo.y, hi.x, hi.y};
            }
        }
        LDS_WAIT(); __syncthreads();
#pragma unroll 1
        for (int d = 1; d < 4; ++d) {
            if (wave < 4 - d) {
                const int bj = wave, bi = wave + d;
                f32x4 x = {0.f, 0.f, 0.f, 0.f};
                for (int k = bj; k < bi; ++k) {
#pragma unroll
                    for (int s4 = 0; s4 < 4; ++s4) {
                        const float av = LMp[(16 * bi + r) * 68 + 16 * k + 4 * s4 + g];
                        const float bv = TF[(16 * k + 4 * s4 + g) * 68 + 16 * bj + r];
                        x = __builtin_amdgcn_mfma_f32_16x16x4f32(av, bv, x, 0, 0, 0);
                    }
                }
#pragma unroll
                for (int e = 0; e < 4; ++e) XS[(4 * g + e) * 17 + r] = x[e];
                LDS_WAIT(); asm volatile("" ::: "memory");
                f32x4 y = {0.f, 0.f, 0.f, 0.f};
#pragma unroll
                for (int s4 = 0; s4 < 4; ++s4) {
                    const float av = TF[(16 * bi + r) * 68 + 16 * bi + 4 * s4 + g];
                    const float bv = XS[(4 * s4 + g) * 17 + r];
                    y = __builtin_amdgcn_mfma_f32_16x16x4f32(av, bv, y, 0, 0, 0);
                }
#pragma unroll
                for (int e = 0; e < 4; ++e) TF[(16 * bi + 4 * g + e) * 68 + 16 * bj + r] = -y[e];
            }
            LDS_WAIT(); __syncthreads();
        }
        {
            const int row = tid >> 3, c0 = 8 * (tid & 7);
            f32x4 v0 = *(const LAS f32x4*)(TF + row * 68 + c0), v1 = *(const LAS f32x4*)(TF + row * 68 + c0 + 4);
            if ((c0 >> 4) > (row >> 4)) { v0 = (f32x4){0.f, 0.f, 0.f, 0.f}; v1 = v0; }
            v4u w; w.x = pk2(v0.x, v0.y); w.y = pk2(v0.z, v0.w); w.z = pk2(v1.x, v1.y); w.w = pk2(v1.z, v1.w);
            *(LAS v4u*)(L + gp::TM + row * 144 + c0 * 2) = w;
        }
    }
    LDS_WAIT(); __syncthreads();
#pragma unroll 1
    for (int idx = 0; idx < 8; ++idx) {
        const int jb = 8 * wave + idx;
        if (jb < 32) {
            const int mt = jb >> 2, nt = jb & 3;
            f32x4 acc = {0.f, 0.f, 0.f, 0.f};
            const LAS unsigned char* pa = L + gp::KBT + (16 * mt + r) * 144 + 16 * g; const LAS unsigned char* pb = L + gp::TM + (16 * nt + r) * 144 + 16 * g;
#pragma unroll
            for (int ks = 0; ks < 2; ++ks) acc = __builtin_amdgcn_mfma_f32_16x16x32_bf16(*(const LAS bf16x8*)(pa + 64 * ks), *(const LAS bf16x8*)(pb + 64 * ks), acc, 0, 0, 0);
            v2u w; w.x = pk2(acc[0], acc[1]); w.y = pk2(acc[2], acc[3]);
            *(GAS v2u*)(F.ws + WS_GW + cidx * 16384 + (size_t)((nt * 4 + (mt >> 1)) * 64 + lane) * 16 + 8 * (mt & 1)) = w;
        } else {
            const int j2 = jb - 32, mt = j2 >> 3, nt = j2 & 7;
            f32x4 acc = {0.f, 0.f, 0.f, 0.f};
            const LAS unsigned char* pa = L + gp::TM + (16 * mt + r) * 144 + 16 * g; const LAS unsigned char* pb = L + gp::VBT + (16 * nt + r) * 144 + 16 * g;
#pragma unroll
            for (int ks = 0; ks < 2; ++ks) acc = __builtin_amdgcn_mfma_f32_16x16x32_bf16(*(const LAS bf16x8*)(pa + 64 * ks), *(const LAS bf16x8*)(pb + 64 * ks), acc, 0, 0, 0);
            { v2u w; w.x = pk2(acc[0], acc[1]); w.y = pk2(acc[2], acc[3]); *(GAS v2u*)(F.ws + WS_GU + cidx * 16384 + (size_t)((nt * 4 + mt) * 64 + lane) * 8) = w; }
        }
    }
    LDS_WAIT(); __syncthreads();
}
DI void copy_g2l(LAS unsigned char* dst, const unsigned char* src, int bytes, int tid) {
    for (int o = tid * 16; o < bytes; o += 512 * 16) *(LAS v4u*)(dst + o) = *(const GAS v4u*)(src + o);
}
DI bf16x8 pack_b(const f32x4& lo, const f32x4& hi) {
    v4u w; w.x = pk2(lo[0], lo[1]); w.y = pk2(lo[2], lo[3]); w.z = pk2(hi[0], hi[1]); w.w = pk2(hi[2], hi[3]);
    return __builtin_bit_cast(bf16x8, w);
}
#define BAR_LDS() do { asm volatile("s_waitcnt lgkmcnt(0)" ::: "memory"); __builtin_amdgcn_s_barrier(); asm volatile("" ::: "memory"); } while (0)
#define MFMA16(a, b, c) __builtin_amdgcn_mfma_f32_16x16x32_bf16((a), (b), (c), 0, 0, 0)

#define BAR_RAW() do { asm volatile("s_waitcnt lgkmcnt(0)" ::: "memory"); __builtin_amdgcn_s_barrier(); asm volatile("" ::: "memory"); } while (0)

DI void gdn_scan(const Frame& F, int bh, int layer, int variant = 0) {
    const int b = bh / 6, h = bh % 6, tid = F.tid, lane = F.lane, wave = F.wave, r = lane & 15, g = lane >> 4;
    LAS unsigned char* L = F.lds;
    constexpr int BUF = 57344, OT = 114688;
    const unsigned char* gw = F.ws + WS_GW + (size_t)bh * 64 * 16384; const unsigned char* gq = F.ws + WS_GQ + (size_t)bh * 64 * 16384;
    const unsigned char* gk = F.ws + WS_GK + (size_t)bh * 64 * 16384; const unsigned char* ga = F.ws + WS_GA + (size_t)bh * 64 * 8192;
    const unsigned char* gu = F.ws + WS_GU + (size_t)bh * 64 * 16384; const float* ge = (const float*)(F.ws + WS_GE) + (size_t)bh * 64;
    copy_g2l(L, gw, 16384, tid); copy_g2l(L + 16384, gq, 16384, tid); copy_g2l(L + 32768, gk, 16384, tid); copy_g2l(L + 49152, ga, 8192, tid);
    BAR_RAW();
    if (wave < 4) {
        f32x4 S[2][8];
#pragma unroll
        for (int n = 0; n < 2; ++n)
#pragma unroll
            for (int i = 0; i < 8; ++i) S[n][i] = (f32x4){0.f, 0.f, 0.f, 0.f};
        float ebs = ge[lane];
        asm volatile("" : "+v"(ebs));
        v2u ua[2][4], ub[2][4];
#pragma unroll
        for (int n = 0; n < 2; ++n)
#pragma unroll
            for (int mt = 0; mt < 4; ++mt) ua[n][mt] = *(const GAS v2u*)(gu + (size_t)(((2 * wave + n) * 4 + mt) * 64 + lane) * 8);
#pragma unroll 1
        for (int c2 = 0; c2 < 64; c2 += 2) {
        {
            const int ch = c2;
            LAS unsigned char* B0 = L + (ch & 1) * BUF;
            const int cn = (ch + 1 < 64) ? ch + 1 : ch;
#pragma unroll
            for (int n = 0; n < 2; ++n)
#pragma unroll
                for (int mt = 0; mt < 4; ++mt) ub[n][mt] = *(const GAS v2u*)(gu + (size_t)cn * 16384 + (size_t)(((2 * wave + n) * 4 + mt) * 64 + lane) * 8);
            const float eb = __builtin_bit_cast(float, __builtin_amdgcn_readlane(__builtin_bit_cast(int, ebs), ch));
            __builtin_amdgcn_sched_barrier(0);
            bf16x8 Sb[2][4];
#pragma unroll
            for (int n = 0; n < 2; ++n)
#pragma unroll
                for (int kb = 0; kb < 4; ++kb) Sb[n][kb] = pack_b(S[n][2 * kb], S[n][2 * kb + 1]);
            const LAS unsigned char* B0l = B0 + lane * 16;
            bf16x8 fr0[4], fr1[4];
            f32x4 o[2][4], vn[2][4]; bf16x8 Vb[2][2];
#pragma unroll
            for (int n = 0; n < 2; ++n)
#pragma unroll
                for (int mt = 0; mt < 4; ++mt) o[n][mt] = (f32x4){0.f, 0.f, 0.f, 0.f};
            if (!(variant & 2)) {
            fr0[0] = *(const LAS bf16x8*)(B0l + 16384 + 0*1024 + 0*1024); fr0[1] = *(const LAS bf16x8*)(B0l + 16384 + 0*1024 + 1*1024); fr0[2] = *(const LAS bf16x8*)(B0l + 16384 + 0*1024 + 2*1024); fr0[3] = *(const LAS bf16x8*)(B0l + 16384 + 0*1024 + 3*1024);
            fr1[0] = *(const LAS bf16x8*)(B0l + 16384 + 4*1024 + 0*1024); fr1[1] = *(const LAS bf16x8*)(B0l + 16384 + 4*1024 + 1*1024); fr1[2] = *(const LAS bf16x8*)(B0l + 16384 + 4*1024 + 2*1024); fr1[3] = *(const LAS bf16x8*)(B0l + 16384 + 4*1024 + 3*1024);
            __builtin_amdgcn_sched_barrier(0);
            { f32x4 c0 = {0.f, 0.f, 0.f, 0.f}, c1 = {0.f, 0.f, 0.f, 0.f};
              c0 = MFMA16(fr0[0], Sb[0][0], c0); c1 = MFMA16(fr0[0], Sb[1][0], c1);
              c0 = MFMA16(fr0[1], Sb[0][1], c0); c1 = MFMA16(fr0[1], Sb[1][1], c1);
              c0 = MFMA16(fr0[2], Sb[0][2], c0); c1 = MFMA16(fr0[2], Sb[1][2], c1);
              c0 = MFMA16(fr0[3], Sb[0][3], c0); c1 = MFMA16(fr0[3], Sb[1][3], c1);
              o[0][0] = c0; o[1][0] = c1; }
            __builtin_amdgcn_sched_barrier(0);
            fr0[0] = *(const LAS bf16x8*)(B0l + 16384 + 8*1024 + 0*1024); fr0[1] = *(const LAS bf16x8*)(B0l + 16384 + 8*1024 + 1*1024); fr0[2] = *(const LAS bf16x8*)(B0l + 16384 + 8*1024 + 2*1024); fr0[3] = *(const LAS bf16x8*)(B0l + 16384 + 8*1024 + 3*1024);
            __builtin_amdgcn_sched_barrier(0);
            { f32x4 c0 = {0.f, 0.f, 0.f, 0.f}, c1 = {0.f, 0.f, 0.f, 0.f};
              c0 = MFMA16(fr1[0], Sb[0][0], c0); c1 = MFMA16(fr1[0], Sb[1][0], c1);
              c0 = MFMA16(fr1[1], Sb[0][1], c0); c1 = MFMA16(fr1[1], Sb[1][1], c1);
              c0 = MFMA16(fr1[2], Sb[0][2], c0); c1 = MFMA16(fr1[2], Sb[1][2], c1);
              c0 = MFMA16(fr1[3], Sb[0][3], c0); c1 = MFMA16(fr1[3], Sb[1][3], c1);
              o[0][1] = c0; o[1][1] = c1; }
            __builtin_amdgcn_sched_barrier(0);
            fr1[0] = *(const LAS bf16x8*)(B0l + 16384 + 12*1024 + 0*1024); fr1[1] = *(const LAS bf16x8*)(B0l + 16384 + 12*1024 + 1*1024); fr1[2] = *(const LAS bf16x8*)(B0l + 16384 + 12*1024 + 2*1024); fr1[3] = *(const LAS bf16x8*)(B0l + 16384 + 12*1024 + 3*1024);
            __builtin_amdgcn_sched_barrier(0);
            { f32x4 c0 = {0.f, 0.f, 0.f, 0.f}, c1 = {0.f, 0.f, 0.f, 0.f};
              c0 = MFMA16(fr0[0], Sb[0][0], c0); c1 = MFMA16(fr0[0], Sb[1][0], c1);
              c0 = MFMA16(fr0[1], Sb[0][1], c0); c1 = MFMA16(fr0[1], Sb[1][1], c1);
              c0 = MFMA16(fr0[2], Sb[0][2], c0); c1 = MFMA16(fr0[2], Sb[1][2], c1);
              c0 = MFMA16(fr0[3], Sb[0][3], c0); c1 = MFMA16(fr0[3], Sb[1][3], c1);
              o[0][2] = c0; o[1][2] = c1; }
            __builtin_amdgcn_sched_barrier(0);
            fr0[0] = *(const LAS bf16x8*)(B0l + 0*1024 + 0*1024); fr0[1] = *(const LAS bf16x8*)(B0l + 0*1024 + 1*1024); fr0[2] = *(const LAS bf16x8*)(B0l + 0*1024 + 2*1024); fr0[3] = *(const LAS bf16x8*)(B0l + 0*1024 + 3*1024);
            __builtin_amdgcn_sched_barrier(0);
            { f32x4 c0 = {0.f, 0.f, 0.f, 0.f}, c1 = {0.f, 0.f, 0.f, 0.f};
              c0 = MFMA16(fr1[0], Sb[0][0], c0); c1 = MFMA16(fr1[0], Sb[1][0], c1);
              c0 = MFMA16(fr1[1], Sb[0][1], c0); c1 = MFMA16(fr1[1], Sb[1][1], c1);
              c0 = MFMA16(fr1[2], Sb[0][2], c0); c1 = MFMA16(fr1[2], Sb[1][2], c1);
              c0 = MFMA16(fr1[3], Sb[0][3], c0); c1 = MFMA16(fr1[3], Sb[1][3], c1);
              o[0][3] = c0; o[1][3] = c1; }
            __builtin_amdgcn_sched_barrier(0);
            fr1[0] = *(const LAS bf16x8*)(B0l + 4*1024 + 0*1024); fr1[1] = *(const LAS bf16x8*)(B0l + 4*1024 + 1*1024); fr1[2] = *(const LAS bf16x8*)(B0l + 4*1024 + 2*1024); fr1[3] = *(const LAS bf16x8*)(B0l + 4*1024 + 3*1024);
            __builtin_amdgcn_sched_barrier(0);
            { f32x4 a0 = {0.f, 0.f, 0.f, 0.f}, a1 = {0.f, 0.f, 0.f, 0.f};
              a0 = MFMA16(fr0[0], Sb[0][0], a0); a1 = MFMA16(fr0[0], Sb[1][0], a1);
              a0 = MFMA16(fr0[1], Sb[0][1], a0); a1 = MFMA16(fr0[1], Sb[1][1], a1);
              a0 = MFMA16(fr0[2], Sb[0][2], a0); a1 = MFMA16(fr0[2], Sb[1][2], a1);
              a0 = MFMA16(fr0[3], Sb[0][3], a0); a1 = MFMA16(fr0[3], Sb[1][3], a1);
              vn[0][0] = (f32x4){bflo(ua[0][0].x), bfhi(ua[0][0].x), bflo(ua[0][0].y), bfhi(ua[0][0].y)} - a0; vn[1][0] = (f32x4){bflo(ua[1][0].x), bfhi(ua[1][0].x), bflo(ua[1][0].y), bfhi(ua[1][0].y)} - a1; }
            __builtin_amdgcn_sched_barrier(0);
            fr0[0] = *(const LAS bf16x8*)(B0l + 8*1024 + 0*1024); fr0[1] = *(const LAS bf16x8*)(B0l + 8*1024 + 1*1024); fr0[2] = *(const LAS bf16x8*)(B0l + 8*1024 + 2*1024); fr0[3] = *(const LAS bf16x8*)(B0l + 8*1024 + 3*1024);
            __builtin_amdgcn_sched_barrier(0);
            { f32x4 a0 = {0.f, 0.f, 0.f, 0.f}, a1 = {0.f, 0.f, 0.f, 0.f};
              a0 = MFMA16(fr1[0], Sb[0][0], a0); a1 = MFMA16(fr1[0], Sb[1][0], a1);
              a0 = MFMA16(fr1[1], Sb[0][1], a0); a1 = MFMA16(fr1[1], Sb[1][1], a1);
              a0 = MFMA16(fr1[2], Sb[0][2], a0); a1 = MFMA16(fr1[2], Sb[1][2], a1);
              a0 = MFMA16(fr1[3], Sb[0][3], a0); a1 = MFMA16(fr1[3], Sb[1][3], a1);
              vn[0][1] = (f32x4){bflo(ua[0][1].x), bfhi(ua[0][1].x), bflo(ua[0][1].y), bfhi(ua[0][1].y)} - a0; vn[1][1] = (f32x4){bflo(ua[1][1].x), bfhi(ua[1][1].x), bflo(ua[1][1].y), bfhi(ua[1][1].y)} - a1; }
            __builtin_amdgcn_sched_barrier(0);
            fr1[0] = *(const LAS bf16x8*)(B0l + 12*1024 + 0*1024); fr1[1] = *(const LAS bf16x8*)(B0l + 12*1024 + 1*1024); fr1[2] = *(const LAS bf16x8*)(B0l + 12*1024 + 2*1024); fr1[3] = *(const LAS bf16x8*)(B0l + 12*1024 + 3*1024);
            __builtin_amdgcn_sched_barrier(0);
            { f32x4 a0 = {0.f, 0.f, 0.f, 0.f}, a1 = {0.f, 0.f, 0.f, 0.f};
              a0 = MFMA16(fr0[0], Sb[0][0], a0); a1 = MFMA16(fr0[0], Sb[1][0], a1);
              a0 = MFMA16(fr0[1], Sb[0][1], a0); a1 = MFMA16(fr0[1], Sb[1][1], a1);
              a0 = MFMA16(fr0[2], Sb[0][2], a0); a1 = MFMA16(fr0[2], Sb[1][2], a1);
              a0 = MFMA16(fr0[3], Sb[0][3], a0); a1 = MFMA16(fr0[3], Sb[1][3], a1);
              vn[0][2] = (f32x4){bflo(ua[0][2].x), bfhi(ua[0][2].x), bflo(ua[0][2].y), bfhi(ua[0][2].y)} - a0; vn[1][2] = (f32x4){bflo(ua[1][2].x), bfhi(ua[1][2].x), bflo(ua[1][2].y), bfhi(ua[1][2].y)} - a1; }
            __builtin_amdgcn_sched_barrier(0);
            fr0[0] = *(const LAS bf16x8*)(B0l + 49152 + 0*1024 + 0*1024); fr0[1] = *(const LAS bf16x8*)(B0l + 49152 + 0*1024 + 1*1024);
            __builtin_amdgcn_sched_barrier(0);
            { f32x4 a0 = {0.f, 0.f, 0.f, 0.f}, a1 = {0.f, 0.f, 0.f, 0.f};
              a0 = MFMA16(fr1[0], Sb[0][0], a0); a1 = MFMA16(fr1[0], Sb[1][0], a1);
              a0 = MFMA16(fr1[1], Sb[0][1], a0); a1 = MFMA16(fr1[1], Sb[1][1], a1);
              a0 = MFMA16(fr1[2], Sb[0][2], a0); a1 = MFMA16(fr1[2], Sb[1][2], a1);
              a0 = MFMA16(fr1[3], Sb[0][3], a0); a1 = MFMA16(fr1[3], Sb[1][3], a1);
              vn[0][3] = (f32x4){bflo(ua[0][3].x), bfhi(ua[0][3].x), bflo(ua[0][3].y), bfhi(ua[0][3].y)} - a0; vn[1][3] = (f32x4){bflo(ua[1][3].x), bfhi(ua[1][3].x), bflo(ua[1][3].y), bfhi(ua[1][3].y)} - a1; }
            Vb[0][0] = pack_b(vn[0][0], vn[0][1]); Vb[0][1] = pack_b(vn[0][2], vn[0][3]); Vb[1][0] = pack_b(vn[1][0], vn[1][1]); Vb[1][1] = pack_b(vn[1][2], vn[1][3]);
            __builtin_amdgcn_sched_barrier(0);
            fr1[0] = *(const LAS bf16x8*)(B0l + 49152 + 2*1024 + 0*1024); fr1[1] = *(const LAS bf16x8*)(B0l + 49152 + 2*1024 + 1*1024);
            __builtin_amdgcn_sched_barrier(0);
            o[0][0] = MFMA16(fr0[0], Vb[0][0], o[0][0]); o[1][0] = MFMA16(fr0[0], Vb[1][0], o[1][0]);
            o[0][0] = MFMA16(fr0[1], Vb[0][1], o[0][0]); o[1][0] = MFMA16(fr0[1], Vb[1][1], o[1][0]);
            __builtin_amdgcn_sched_barrier(0);
            fr0[0] = *(const LAS bf16x8*)(B0l + 49152 + 4*1024 + 0*1024); fr0[1] = *(const LAS bf16x8*)(B0l + 49152 + 4*1024 + 1*1024);
            __builtin_amdgcn_sched_barrier(0);
            o[0][1] = MFMA16(fr1[0], Vb[0][0], o[0][1]); o[1][1] = MFMA16(fr1[0], Vb[1][0], o[1][1]);
            o[0][1] = MFMA16(fr1[1], Vb[0][1], o[0][1]); o[1][1] = MFMA16(fr1[1], Vb[1][1], o[1][1]);
            __builtin_amdgcn_sched_barrier(0);
            fr1[0] = *(const LAS bf16x8*)(B0l + 49152 + 6*1024 + 0*1024); fr1[1] = *(const LAS bf16x8*)(B0l + 49152 + 6*1024 + 1*1024);
            __builtin_amdgcn_sched_barrier(0);
            o[0][2] = MFMA16(fr0[0], Vb[0][0], o[0][2]); o[1][2] = MFMA16(fr0[0], Vb[1][0], o[1][2]);
            o[0][2] = MFMA16(fr0[1], Vb[0][1], o[0][2]); o[1][2] = MFMA16(fr0[1], Vb[1][1], o[1][2]);
            __builtin_amdgcn_sched_barrier(0);
            fr0[0] = *(const LAS bf16x8*)(B0l + 32768 + 0*1024 + 0*1024); fr0[1] = *(const LAS bf16x8*)(B0l + 32768 + 0*1024 + 1*1024);
            __builtin_amdgcn_sched_barrier(0);
            o[0][3] = MFMA16(fr1[0], Vb[0][0], o[0][3]); o[1][3] = MFMA16(fr1[0], Vb[1][0], o[1][3]);
            o[0][3] = MFMA16(fr1[1], Vb[0][1], o[0][3]); o[1][3] = MFMA16(fr1[1], Vb[1][1], o[1][3]);
            __builtin_amdgcn_sched_barrier(0);
            fr1[0] = *(const LAS bf16x8*)(B0l + 32768 + 2*1024 + 0*1024); fr1[1] = *(const LAS bf16x8*)(B0l + 32768 + 2*1024 + 1*1024);
            __builtin_amdgcn_sched_barrier(0);
            { f32x4 a0 = S[0][0] * eb, a1 = S[1][0] * eb;
              a0 = MFMA16(fr0[0], Vb[0][0], a0); a1 = MFMA16(fr0[0], Vb[1][0], a1);
              a0 = MFMA16(fr0[1], Vb[0][1], a0); a1 = MFMA16(fr0[1], Vb[1][1], a1);
              S[0][0] = a0; S[1][0] = a1; }
            __builtin_amdgcn_sched_barrier(0);
            fr0[0] = *(const LAS bf16x8*)(B0l + 32768 + 4*1024 + 0*1024); fr0[1] = *(const LAS bf16x8*)(B0l + 32768 + 4*1024 + 1*1024);
            __builtin_amdgcn_sched_barrier(0);
            { f32x4 a0 = S[0][1] * eb, a1 = S[1][1] * eb;
              a0 = MFMA16(fr1[0], Vb[0][0], a0); a1 = MFMA16(fr1[0], Vb[1][0], a1);
              a0 = MFMA16(fr1[1], Vb[0][1], a0); a1 = MFMA16(fr1[1], Vb[1][1], a1);
              S[0][1] = a0; S[1][1] = a1; }
            __builtin_amdgcn_sched_barrier(0);
            fr1[0] = *(const LAS bf16x8*)(B0l + 32768 + 6*1024 + 0*1024); fr1[1] = *(const LAS bf16x8*)(B0l + 32768 + 6*1024 + 1*1024);
            __builtin_amdgcn_sched_barrier(0);
            { f32x4 a0 = S[0][2] * eb, a1 = S[1][2] * eb;
              a0 = MFMA16(fr0[0], Vb[0][0], a0); a1 = MFMA16(fr0[0], Vb[1][0], a1);
              a0 = MFMA16(fr0[1], Vb[0][1], a0); a1 = MFMA16(fr0[1], Vb[1][1], a1);
              S[0][2] = a0; S[1][2] = a1; }
            __builtin_amdgcn_sched_barrier(0);
            fr0[0] = *(const LAS bf16x8*)(B0l + 32768 + 8*1024 + 0*1024); fr0[1] = *(const LAS bf16x8*)(B0l + 32768 + 8*1024 + 1*1024);
            __builtin_amdgcn_sched_barrier(0);
            { f32x4 a0 = S[0][3] * eb, a1 = S[1][3] * eb;
              a0 = MFMA16(fr1[0], Vb[0][0], a0); a1 = MFMA16(fr1[0], Vb[1][0], a1);
              a0 = MFMA16(fr1[1], Vb[0][1], a0); a1 = MFMA16(fr1[1], Vb[1][1], a1);
              S[0][3] = a0; S[1][3] = a1; }
            __builtin_amdgcn_sched_barrier(0);
            fr1[0] = *(const LAS bf16x8*)(B0l + 32768 + 10*1024 + 0*1024); fr1[1] = *(const LAS bf16x8*)(B0l + 32768 + 10*1024 + 1*1024);
            __builtin_amdgcn_sched_barrier(0);
            { f32x4 a0 = S[0][4] * eb, a1 = S[1][4] * eb;
              a0 = MFMA16(fr0[0], Vb[0][0], a0); a1 = MFMA16(fr0[0], Vb[1][0], a1);
              a0 = MFMA16(fr0[1], Vb[0][1], a0); a1 = MFMA16(fr0[1], Vb[1][1], a1);
              S[0][4] = a0; S[1][4] = a1; }
            __builtin_amdgcn_sched_barrier(0);
            fr0[0] = *(const LAS bf16x8*)(B0l + 32768 + 12*1024 + 0*1024); fr0[1] = *(const LAS bf16x8*)(B0l + 32768 + 12*1024 + 1*1024);
            __builtin_amdgcn_sched_barrier(0);
            { f32x4 a0 = S[0][5] * eb, a1 = S[1][5] * eb;
              a0 = MFMA16(fr1[0], Vb[0][0], a0); a1 = MFMA16(fr1[0], Vb[1][0], a1);
              a0 = MFMA16(fr1[1], Vb[0][1], a0); a1 = MFMA16(fr1[1], Vb[1][1], a1);
              S[0][5] = a0; S[1][5] = a1; }
            __builtin_amdgcn_sched_barrier(0);
            fr1[0] = *(const LAS bf16x8*)(B0l + 32768 + 14*1024 + 0*1024); fr1[1] = *(const LAS bf16x8*)(B0l + 32768 + 14*1024 + 1*1024);
            __builtin_amdgcn_sched_barrier(0);
            { f32x4 a0 = S[0][6] * eb, a1 = S[1][6] * eb;
              a0 = MFMA16(fr0[0], Vb[0][0], a0); a1 = MFMA16(fr0[0], Vb[1][0], a1);
              a0 = MFMA16(fr0[1], Vb[0][1], a0); a1 = MFMA16(fr0[1], Vb[1][1], a1);
              S[0][6] = a0; S[1][6] = a1; }
            __builtin_amdgcn_sched_barrier(0);
            __builtin_amdgcn_sched_barrier(0);
            { f32x4 a0 = S[0][7] * eb, a1 = S[1][7] * eb;
              a0 = MFMA16(fr1[0], Vb[0][0], a0); a1 = MFMA16(fr1[0], Vb[1][0], a1);
              a0 = MFMA16(fr1[1], Vb[0][1], a0); a1 = MFMA16(fr1[1], Vb[1][1], a1);
              S[0][7] = a0; S[1][7] = a1; }
            __builtin_amdgcn_sched_barrier(0);
            }
            BAR_RAW();
#pragma unroll
            for (int n = 0; n < 2; ++n)
#pragma unroll
                for (int mt = 0; mt < 4; ++mt)
#pragma unroll
                    for (int e = 0; e < 4; ++e) ((LAS float*)(L + OT))[(16 * mt + 4 * g + e) * 132 + 32 * wave + 16 * n + r] = o[n][mt][e];
            BAR_RAW();
        }

        {
            const int ch = c2 + 1;
            LAS unsigned char* B0 = L + (ch & 1) * BUF;
            const int cn = (ch + 1 < 64) ? ch + 1 : ch;
#pragma unroll
            for (int n = 0; n < 2; ++n)
#pragma unroll
                for (int mt = 0; mt < 4; ++mt) ua[n][mt] = *(const GAS v2u*)(gu + (size_t)cn * 16384 + (size_t)(((2 * wave + n) * 4 + mt) * 64 + lane) * 8);
            const float eb = __builtin_bit_cast(float, __builtin_amdgcn_readlane(__builtin_bit_cast(int, ebs), ch));
            __builtin_amdgcn_sched_barrier(0);
            bf16x8 Sb[2][4];
#pragma unroll
            for (int n = 0; n < 2; ++n)
#pragma unroll
                for (int kb = 0; kb < 4; ++kb) Sb[n][kb] = pack_b(S[n][2 * kb], S[n][2 * kb + 1]);
            const LAS unsigned char* B0l = B0 + lane * 16;
            bf16x8 fr0[4], fr1[4];
            f32x4 o[2][4], vn[2][4]; bf16x8 Vb[2][2];
#pragma unroll
            for (int n = 0; n < 2; ++n)
#pragma unroll
                for (int mt = 0; mt < 4; ++mt) o[n][mt] = (f32x4){0.f, 0.f, 0.f, 0.f};
            if (!(variant & 2)) {
            fr0[0] = *(const LAS bf16x8*)(B0l + 16384 + 0*1024 + 0*1024); fr0[1] = *(const LAS bf16x8*)(B0l + 16384 + 0*1024 + 1*1024); fr0[2] = *(const LAS bf16x8*)(B0l + 16384 + 0*1024 + 2*1024); fr0[3] = *(const LAS bf16x8*)(B0l + 16384 + 0*1024 + 3*1024);
            fr1[0] = *(const LAS bf16x8*)(B0l + 16384 + 4*1024 + 0*1024); fr1[1] = *(const LAS bf16x8*)(B0l + 16384 + 4*1024 + 1*1024); fr1[2] = *(const LAS bf16x8*)(B0l + 16384 + 4*1024 + 2*1024); fr1[3] = *(const LAS bf16x8*)(B0l + 16384 + 4*1024 + 3*1024);
            __builtin_amdgcn_sched_barrier(0);
            { f32x4 c0 = {0.f, 0.f, 0.f, 0.f}, c1 = {0.f, 0.f, 0.f, 0.f};
              c0 = MFMA16(fr0[0], Sb[0][0], c0); c1 = MFMA16(fr0[0], Sb[1][0], c1);
              c0 = MFMA16(fr0[1], Sb[0][1], c0); c1 = MFMA16(fr0[1], Sb[1][1], c1);
              c0 = MFMA16(fr0[2], Sb[0][2], c0); c1 = MFMA16(fr0[2], Sb[1][2], c1);
              c0 = MFMA16(fr0[3], Sb[0][3], c0); c1 = MFMA16(fr0[3], Sb[1][3], c1);
              o[0][0] = c0; o[1][0] = c1; }
            __builtin_amdgcn_sched_barrier(0);
            fr0[0] = *(const LAS bf16x8*)(B0l + 16384 + 8*1024 + 0*1024); fr0[1] = *(const LAS bf16x8*)(B0l + 16384 + 8*1024 + 1*1024); fr0[2] = *(const LAS bf16x8*)(B0l + 16384 + 8*1024 + 2*1024); fr0[3] = *(const LAS bf16x8*)(B0l + 16384 + 8*1024 + 3*1024);
            __builtin_amdgcn_sched_barrier(0);
            { f32x4 c0 = {0.f, 0.f, 0.f, 0.f}, c1 = {0.f, 0.f, 0.f, 0.f};
              c0 = MFMA16(fr1[0], Sb[0][0], c0); c1 = MFMA16(fr1[0], Sb[1][0], c1);
              c0 = MFMA16(fr1[1], Sb[0][1], c0); c1 = MFMA16(fr1[1], Sb[1][1], c1);
              c0 = MFMA16(fr1[2], Sb[0][2], c0); c1 = MFMA16(fr1[2], Sb[1][2], c1);
              c0 = MFMA16(fr1[3], Sb[0][3], c0); c1 = MFMA16(fr1[3], Sb[1][3], c1);
              o[0][1] = c0; o[1][1] = c1; }
            __builtin_amdgcn_sched_barrier(0);
            fr1[0] = *(const LAS bf16x8*)(B0l + 16384 + 12*1024 + 0*1024); fr1[1] = *(const LAS bf16x8*)(B0l + 16384 + 12*1024 + 1*1024); fr1[2] = *(const LAS bf16x8*)(B0l + 16384 + 12*1024 + 2*1024); fr1[3] = *(const LAS bf16x8*)(B0l + 16384 + 12*1024 + 3*1024);
            __builtin_amdgcn_sched_barrier(0);
            { f32x4 c0 = {0.f, 0.f, 0.f, 0.f}, c1 = {0.f, 0.f, 0.f, 0.f};
              c0 = MFMA16(fr0[0], Sb[0][0], c0); c1 = MFMA16(fr0[0], Sb[1][0], c1);
              c0 = MFMA16(fr0[1], Sb[0][1], c0); c1 = MFMA16(fr0[1], Sb[1][1], c1);
              c0 = MFMA16(fr0[2], Sb[0][2], c0); c1 = MFMA16(fr0[2], Sb[1][2], c1);
              c0 = MFMA16(fr0[3], Sb[0][3], c0); c1 = MFMA16(fr0[3], Sb[1][3], c1);
              o[0][2] = c0; o[1][2] = c1; }
            __builtin_amdgcn_sched_barrier(0);
            fr0[0] = *(const LAS bf16x8*)(B0l + 0*1024 + 0*1024); fr0[1] = *(const LAS bf16x8*)(B0l + 0*1024 + 1*1024); fr0[2] = *(const LAS bf16x8*)(B0l + 0*1024 + 2*1024); fr0[3] = *(const LAS bf16x8*)(B0l + 0*1024 + 3*1024);
            __builtin_amdgcn_sched_barrier(0);
            { f32x4 c0 = {0.f, 0.f, 0.f, 0.f}, c1 = {0.f, 0.f, 0.f, 0.f};
              c0 = MFMA16(fr1[0], Sb[0][0], c0); c1 = MFMA16(fr1[0], Sb[1][0], c1);
              c0 = MFMA16(fr1[1], Sb[0][1], c0); c1 = MFMA16(fr1[1], Sb[1][1], c1);
              c0 = MFMA16(fr1[2], Sb[0][2], c0); c1 = MFMA16(fr1[2], Sb[1][2], c1);
              c0 = MFMA16(fr1[3], Sb[0][3], c0); c1 = MFMA16(fr1[3], Sb[1][3], c1);
              o[0][3] = c0; o[1][3] = c1; }
            __builtin_amdgcn_sched_barrier(0);
            fr1[0] = *(const LAS bf16x8*)(B0l + 4*1024 + 0*1024); fr1[1] = *(const LAS bf16x8*)(B0l + 4*1024 + 1*1024); fr1[2] = *(const LAS bf16x8*)(B0l + 4*1024 + 2*1024); fr1[3] = *(const LAS bf16x8*)(B0l + 4*1024 + 3*1024);
            __builtin_amdgcn_sched_barrier(0);
            { f32x4 a0 = {0.f, 0.f, 0.f, 0.f}, a1 = {0.f, 0.f, 0.f, 0.f};
              a0 = MFMA16(fr0[0], Sb[0][0], a0); a1 = MFMA16(fr0[0], Sb[1][0], a1);
              a0 = MFMA16(fr0[1], Sb[0][1], a0); a1 = MFMA16(fr0[1], Sb[1][1], a1);
              a0 = MFMA16(fr0[2], Sb[0][2], a0); a1 = MFMA16(fr0[2], Sb[1][2], a1);
              a0 = MFMA16(fr0[3], Sb[0][3], a0); a1 = MFMA16(fr0[3], Sb[1][3], a1);
              vn[0][0] = (f32x4){bflo(ub[0][0].x), bfhi(ub[0][0].x), bflo(ub[0][0].y), bfhi(ub[0][0].y)} - a0; vn[1][0] = (f32x4){bflo(ub[1][0].x), bfhi(ub[1][0].x), bflo(ub[1][0].y), bfhi(ub[1][0].y)} - a1; }
            __builtin_amdgcn_sched_barrier(0);
            fr0[0] = *(const LAS bf16x8*)(B0l + 8*1024 + 0*1024); fr0[1] = *(const LAS bf16x8*)(B0l + 8*1024 + 1*1024); fr0[2] = *(const LAS bf16x8*)(B0l + 8*1024 + 2*1024); fr0[3] = *(const LAS bf16x8*)(B0l + 8*1024 + 3*1024);
            __builtin_amdgcn_sched_barrier(0);
            { f32x4 a0 = {0.f, 0.f, 0.f, 0.f}, a1 = {0.f, 0.f, 0.f, 0.f};
              a0 = MFMA16(fr1[0], Sb[0][0], a0); a1 = MFMA16(fr1[0], Sb[1][0], a1);
              a0 = MFMA16(fr1[1], Sb[0][1], a0); a1 = MFMA16(fr1[1], Sb[1][1], a1);
              a0 = MFMA16(fr1[2], Sb[0][2], a0); a1 = MFMA16(fr1[2], Sb[1][2], a1);
              a0 = MFMA16(fr1[3], Sb[0][3], a0); a1 = MFMA16(fr1[3], Sb[1][3], a1);
              vn[0][1] = (f32x4){bflo(ub[0][1].x), bfhi(ub[0][1].x), bflo(ub[0][1].y), bfhi(ub[0][1].y)} - a0; vn[1][1] = (f32x4){bflo(ub[1][1].x), bfhi(ub[1][1].x), bflo(ub[1][1].y), bfhi(ub[1][1].y)} - a1; }
            __builtin_amdgcn_sched_barrier(0);
            fr1[0] = *(const LAS bf16x8*)(B0l + 12*1024 + 0*1024); fr1[1] = *(const LAS bf16x8*)(B0l + 12*1024 + 1*1024); fr1[2] = *(const LAS bf16x8*)(B0l + 12*1024 + 2*1024); fr1[3] = *(const LAS bf16x8*)(B0l + 12*1024 + 3*1024);
            __builtin_amdgcn_sched_barrier(0);
            { f32x4 a0 = {0.f, 0.f, 0.f, 0.f}, a1 = {0.f, 0.f, 0.f, 0.f};
              a0 = MFMA16(fr0[0], Sb[0][0], a0); a1 = MFMA16(fr0[0], Sb[1][0], a1);
              a0 = MFMA16(fr0[1], Sb[0][1], a0); a1 = MFMA16(fr0[1], Sb[1][1], a1);
              a0 = MFMA16(fr0[2], Sb[0][2], a0); a1 = MFMA16(fr0[2], Sb[1][2], a1);
              a0 = MFMA16(fr0[3], Sb[0][3], a0); a1 = MFMA16(fr0[3], Sb[1][3], a1);
              vn[0][2] = (f32x4){bflo(ub[0][2].x), bfhi(ub[0][2].x), bflo(ub[0][2].y), bfhi(ub[0][2].y)} - a0; vn[1][2] = (f32x4){bflo(ub[1][2].x), bfhi(ub[1][2].x), bflo(ub[1][2].y), bfhi(ub[1][2].y)} - a1; }
            __builtin_amdgcn_sched_barrier(0);
            fr0[0] = *(const LAS bf16x8*)(B0l + 49152 + 0*1024 + 0*1024); fr0[1] = *(const LAS bf16x8*)(B0l + 49152 + 0*1024 + 1*1024);
            __builtin_amdgcn_sched_barrier(0);
            { f32x4 a0 = {0.f, 0.f, 0.f, 0.f}, a1 = {0.f, 0.f, 0.f, 0.f};
              a0 = MFMA16(fr1[0], Sb[0][0], a0); a1 = MFMA16(fr1[0], Sb[1][0], a1);
              a0 = MFMA16(fr1[1], Sb[0][1], a0); a1 = MFMA16(fr1[1], Sb[1][1], a1);
              a0 = MFMA16(fr1[2], Sb[0][2], a0); a1 = MFMA16(fr1[2], Sb[1][2], a1);
              a0 = MFMA16(fr1[3], Sb[0][3], a0); a1 = MFMA16(fr1[3], Sb[1][3], a1);
              vn[0][3] = (f32x4){bflo(ub[0][3].x), bfhi(ub[0][3].x), bflo(ub[0][3].y), bfhi(ub[0][3].y)} - a0; vn[1][3] = (f32x4){bflo(ub[1][3].x), bfhi(ub[1][3].x), bflo(ub[1][3].y), bfhi(ub[1][3].y)} - a1; }
            Vb[0][0] = pack_b(vn[0][0], vn[0][1]); Vb[0][1] = pack_b(vn[0][2], vn[0][3]); Vb[1][0] = pack_b(vn[1][0], vn[1][1]); Vb[1][1] = pack_b(vn[1][2], vn[1][3]);
            __builtin_amdgcn_sched_barrier(0);
            fr1[0] = *(const LAS bf16x8*)(B0l + 49152 + 2*1024 + 0*1024); fr1[1] = *(const LAS bf16x8*)(B0l + 49152 + 2*1024 + 1*1024);
            __builtin_amdgcn_sched_barrier(0);
            o[0][0] = MFMA16(fr0[0], Vb[0][0], o[0][0]); o[1][0] = MFMA16(fr0[0], Vb[1][0], o[1][0]);
            o[0][0] = MFMA16(fr0[1], Vb[0][1], o[0][0]); o[1][0] = MFMA16(fr0[1], Vb[1][1], o[1][0]);
            __builtin_amdgcn_sched_barrier(0);
            fr0[0] = *(const LAS bf16x8*)(B0l + 49152 + 4*1024 + 0*1024); fr0[1] = *(const LAS bf16x8*)(B0l + 49152 + 4*1024 + 1*1024);
            __builtin_amdgcn_sched_barrier(0);
            o[0][1] = MFMA16(fr1[0], Vb[0][0], o[0][1]); o[1][1] = MFMA16(fr1[0], Vb[1][0], o[1][1]);
            o[0][1] = MFMA16(fr1[1], Vb[0][1], o[0][1]); o[1][1] = MFMA16(fr1[1], Vb[1][1], o[1][1]);
            __builtin_amdgcn_sched_barrier(0);
            fr1[0] = *(const LAS bf16x8*)(B0l + 49152 + 6*1024 + 0*1024); fr1[1] = *(const LAS bf16x8*)(B0l + 49152 + 6*1024 + 1*1024);
            __builtin_amdgcn_sched_barrier(0);
            o[0][2] = MFMA16(fr0[0], Vb[0][0], o[0][2]); o[1][2] = MFMA16(fr0[0], Vb[1][0], o[1][2]);
            o[0][2] = MFMA16(fr0[1], Vb[0][1], o[0][2]); o[1][2] = MFMA16(fr0[1], Vb[1][1], o[1][2]);
            __builtin_amdgcn_sched_barrier(0);
            fr0[0] = *(const LAS bf16x8*)(B0l + 32768 + 0*1024 + 0*1024); fr0[1] = *(const LAS bf16x8*)(B0l + 32768 + 0*1024 + 1*1024);
            __builtin_amdgcn_sched_barrier(0);
            o[0][3] = MFMA16(fr1[0], Vb[0][0], o[0][3]); o[1][3] = MFMA16(fr1[0], Vb[1][0], o[1][3]);
            o[0][3] = MFMA16(fr1[1], Vb[0][1], o[0][3]); o[1][3] = MFMA16(fr1[1], Vb[1][1], o[1][3]);
            __builtin_amdgcn_sched_barrier(0);
            fr1[0] = *(const LAS bf16x8*)(B0l + 32768 + 2*1024 + 0*1024); fr1[1] = *(const LAS bf16x8*)(B0l + 32768 + 2*1024 + 1*1024);
            __builtin_amdgcn_sched_barrier(0);
            { f32x4 a0 = S[0][0] * eb, a1 = S[1][0] * eb;
              a0 = MFMA16(fr0[0], Vb[0][0], a0); a1 = MFMA16(fr0[0], Vb[1][0], a1);
              a0 = MFMA16(fr0[1], Vb[0][1], a0); a1 = MFMA16(fr0[1], Vb[1][1], a1);
              S[0][0] = a0; S[1][0] = a1; }
            __builtin_amdgcn_sched_barrier(0);
            fr0[0] = *(const LAS bf16x8*)(B0l + 32768 + 4*1024 + 0*1024); fr0[1] = *(const LAS bf16x8*)(B0l + 32768 + 4*1024 + 1*1024);
            __builtin_amdgcn_sched_barrier(0);
            { f32x4 a0 = S[0][1] * eb, a1 = S[1][1] * eb;
              a0 = MFMA16(fr1[0], Vb[0][0], a0); a1 = MFMA16(fr1[0], Vb[1][0], a1);
              a0 = MFMA16(fr1[1], Vb[0][1], a0); a1 = MFMA16(fr1[1], Vb[1][1], a1);
              S[0][1] = a0; S[1][1] = a1; }
            __builtin_amdgcn_sched_barrier(0);
            fr1[0] = *(const LAS bf16x8*)(B0l + 32768 + 6*1024 + 0*1024); fr1[1] = *(const LAS bf16x8*)(B0l + 32768 + 6*1024 + 1*1024);
            __builtin_amdgcn_sched_barrier(0);
            { f32x4 a0 = S[0][2] * eb, a1 = S[1][2] * eb;
              a0 = MFMA16(fr0[0], Vb[0][0], a0); a1 = MFMA16(fr0[0], Vb[1][0], a1);
              a0 = MFMA16(fr0[1], Vb[0][1], a0); a1 = MFMA16(fr0[1], Vb[1][1], a1);
              S[0][2] = a0; S[1][2] = a1; }
            __builtin_amdgcn_sched_barrier(0);
            fr0[0] = *(const LAS bf16x8*)(B0l + 32768 + 8*1024 + 0*1024); fr0[1] = *(const LAS bf16x8*)(B0l + 32768 + 8*1024 + 1*1024);
            __builtin_amdgcn_sched_barrier(0);
            { f32x4 a0 = S[0][3] * eb, a1 = S[1][3] * eb;
              a0 = MFMA16(fr1[0], Vb[0][0], a0); a1 = MFMA16(fr1[0], Vb[1][0], a1);
              a0 = MFMA16(fr1[1], Vb[0][1], a0); a1 = MFMA16(fr1[1], Vb[1][1], a1);
              S[0][3] = a0; S[1][3] = a1; }
            __builtin_amdgcn_sched_barrier(0);
            fr1[0] = *(const LAS bf16x8*)(B0l + 32768 + 10*1024 + 0*1024); fr1[1] = *(const LAS bf16x8*)(B0l + 32768 + 10*1024 + 1*1024);
            __builtin_amdgcn_sched_barrier(0);
            { f32x4 a0 = S[0][4] * eb, a1 = S[1][4] * eb;
              a0 = MFMA16(fr0[0], Vb[0][0], a0); a1 = MFMA16(fr0[0], Vb[1][0], a1);
              a0 = MFMA16(fr0[1], Vb[0][1], a0); a1 = MFMA16(fr0[1], Vb[1][1], a1);
              S[0][4] = a0; S[1][4] = a1; }
            __builtin_amdgcn_sched_barrier(0);
            fr0[0] = *(const LAS bf16x8*)(B0l + 32768 + 12*1024 + 0*1024); fr0[1] = *(const LAS bf16x8*)(B0l + 32768 + 12*1024 + 1*1024);
            __builtin_amdgcn_sched_barrier(0);
            { f32x4 a0 = S[0][5] * eb, a1 = S[1][5] * eb;
              a0 = MFMA16(fr1[0], Vb[0][0], a0); a1 = MFMA16(fr1[0], Vb[1][0], a1);
              a0 = MFMA16(fr1[1], Vb[0][1], a0); a1 = MFMA16(fr1[1], Vb[1][1], a1);
              S[0][5] = a0; S[1][5] = a1; }
            __builtin_amdgcn_sched_barrier(0);
            fr1[0] = *(const LAS bf16x8*)(B0l + 32768 + 14*1024 + 0*1024); fr1[1] = *(const LAS bf16x8*)(B0l + 32768 + 14*1024 + 1*1024);
            __builtin_amdgcn_sched_barrier(0);
            { f32x4 a0 = S[0][6] * eb, a1 = S[1][6] * eb;
              a0 = MFMA16(fr0[0], Vb[0][0], a0); a1 = MFMA16(fr0[0], Vb[1][0], a1);
              a0 = MFMA16(fr0[1], Vb[0][1], a0); a1 = MFMA16(fr0[1], Vb[1][1], a1);
              S[0][6] = a0; S[1][6] = a1; }
            __builtin_amdgcn_sched_barrier(0);
            __builtin_amdgcn_sched_barrier(0);
            { f32x4 a0 = S[0][7] * eb, a1 = S[1][7] * eb;
              a0 = MFMA16(fr1[0], Vb[0][0], a0); a1 = MFMA16(fr1[0], Vb[1][0], a1);
              a0 = MFMA16(fr1[1], Vb[0][1], a0); a1 = MFMA16(fr1[1], Vb[1][1], a1);
              S[0][7] = a0; S[1][7] = a1; }
            __builtin_amdgcn_sched_barrier(0);
            }
            BAR_RAW();
#pragma unroll
            for (int n = 0; n < 2; ++n)
#pragma unroll
                for (int mt = 0; mt < 4; ++mt)
#pragma unroll
                    for (int e = 0; e < 4; ++e) ((LAS float*)(L + OT))[(16 * mt + 4 * g + e) * 132 + 32 * wave + 16 * n + r] = o[n][mt][e];
            BAR_RAW();
        }

        }
        BAR_RAW(); BAR_RAW();
    } else {
        if (wave < 6) {
            const int l16 = lane * 16, w2 = 2 * (wave - 4);
#define GDN_DMA(CK) do { const int ck_ = (CK); LAS unsigned char* Bd_ = L + (ck_ & 1) * BUF + w2 * 1024; const size_t o16_ = (size_t)ck_ * 16384 + w2 * 1024 + l16, o8_ = (size_t)ck_ * 8192 + w2 * 1024 + l16; \
            _Pragma("unroll") for (int k = 0; k < 4; ++k) _Pragma("unroll") for (int i = 0; i < 2; ++i) { \
                __builtin_amdgcn_global_load_lds((const unsigned*)(gw + o16_ + k * 4096 + i * 1024), (LAS unsigned*)(Bd_ + k * 4096 + i * 1024), 16, 0, 0); \
                __builtin_amdgcn_global_load_lds((const unsigned*)(gq + o16_ + k * 4096 + i * 1024), (LAS unsigned*)(Bd_ + 16384 + k * 4096 + i * 1024), 16, 0, 0); \
                __builtin_amdgcn_global_load_lds((const unsigned*)(gk + o16_ + k * 4096 + i * 1024), (LAS unsigned*)(Bd_ + 32768 + k * 4096 + i * 1024), 16, 0, 0); } \
            _Pragma("unroll") for (int k = 0; k < 2; ++k) _Pragma("unroll") for (int i = 0; i < 2; ++i) \
                __builtin_amdgcn_global_load_lds((const unsigned*)(ga + o8_ + k * 4096 + i * 1024), (LAS unsigned*)(Bd_ + 49152 + k * 4096 + i * 1024), 16, 0, 0); } while (0)
            GDN_DMA(1);
#pragma unroll 1
            for (int ch = 0; ch < 65; ++ch) {
                BAR_RAW();
                asm volatile("s_waitcnt vmcnt(0)" ::: "memory");
                BAR_RAW();
                if (ch + 2 < 64) GDN_DMA(ch + 2);
            }
#undef GDN_DMA
        } else {
            const int hn = tid - 384, nt_t = hn >> 1, nt_c0 = 64 * (hn & 1);
            bf16* MIX = (bf16*)(F.ws + WS_MIX);
            const bf16* zbase = (const bf16*)(F.ws + WS_GZ) + ((size_t)bh * SEQ + nt_t) * 128 + nt_c0;
            v4u za[8], zb[8];
#pragma unroll
            for (int i = 0; i < 8; ++i) { za[i] = (v4u){0u, 0u, 0u, 0u}; zb[i] = (v4u){0u, 0u, 0u, 0u}; }
#pragma unroll 1
            for (int c2 = 0; c2 < 66; c2 += 2) {
            {
                const int ch = c2;
                const int cz = (ch < 64) ? ch : 63;
#pragma unroll
                for (int i = 0; i < 8; ++i) zb[i] = *(const GAS v4u*)(zbase + (size_t)cz * 64 * 128 + 8 * i);
                __builtin_amdgcn_sched_barrier(0);
                if (ch > 0 && !(variant & 1)) {
                    const size_t m = (size_t)b * SEQ + (ch - 1) * 64 + nt_t;
                    const LAS float* op = (const LAS float*)(L + OT) + nt_t * 132 + nt_c0;
                    f32x4 x[16]; float ss = 0.f;
#pragma unroll
                    for (int q4 = 0; q4 < 16; ++q4) { x[q4] = *(const LAS f32x4*)(op + 4 * q4); ss += (x[q4].x * x[q4].x + x[q4].y * x[q4].y) + (x[q4].z * x[q4].z + x[q4].w * x[q4].w); }
                    ss += __shfl_xor(ss, 1);
                    const float rs = frsq(ss * (1.f / 128.f) + EPS);
                    bf16* mp = MIX + m * D + MIX_C + h * 128 + nt_c0;
#pragma unroll
                    for (int i = 0; i < 8; ++i) {
                        const f32x4 xa = x[2 * i] * rs, xb = x[2 * i + 1] * rs;
                        v4u w;
                        w.x = pk2(xa.x * bflo(za[i].x), xa.y * bfhi(za[i].x)); w.y = pk2(xa.z * bflo(za[i].y), xa.w * bfhi(za[i].y));
                        w.z = pk2(xb.x * bflo(za[i].z), xb.y * bfhi(za[i].z)); w.w = pk2(xb.z * bflo(za[i].w), xb.w * bfhi(za[i].w));
                        *(GAS v4u*)(mp + 8 * i) = w;
                    }
                }
                BAR_RAW();
                BAR_RAW();
            }

                if (c2 + 1 > 64) break;
            {
                const int ch = c2 + 1;
                const int cz = (ch < 64) ? ch : 63;
#pragma unroll
                for (int i = 0; i < 8; ++i) za[i] = *(const GAS v4u*)(zbase + (size_t)cz * 64 * 128 + 8 * i);
                __builtin_amdgcn_sched_barrier(0);
                if (ch > 0 && !(variant & 1)) {
                    const size_t m = (size_t)b * SEQ + (ch - 1) * 64 + nt_t;
                    const LAS float* op = (const LAS float*)(L + OT) + nt_t * 132 + nt_c0;
                    f32x4 x[16]; float ss = 0.f;
#pragma unroll
                    for (int q4 = 0; q4 < 16; ++q4) { x[q4] = *(const LAS f32x4*)(op + 4 * q4); ss += (x[q4].x * x[q4].x + x[q4].y * x[q4].y) + (x[q4].z * x[q4].z + x[q4].w * x[q4].w); }
                    ss += __shfl_xor(ss, 1);
                    const float rs = frsq(ss * (1.f / 128.f) + EPS);
                    bf16* mp = MIX + m * D + MIX_C + h * 128 + nt_c0;
#pragma unroll
                    for (int i = 0; i < 8; ++i) {
                        const f32x4 xa = x[2 * i] * rs, xb = x[2 * i + 1] * rs;
                        v4u w;
                        w.x = pk2(xa.x * bflo(zb[i].x), xa.y * bfhi(zb[i].x)); w.y = pk2(xa.z * bflo(zb[i].y), xa.w * bfhi(zb[i].y));
                        w.z = pk2(xb.x * bflo(zb[i].z), xb.y * bfhi(zb[i].z)); w.w = pk2(xb.z * bflo(zb[i].w), xb.w * bfhi(zb[i].w));
                        *(GAS v4u*)(mp + 8 * i) = w;
                    }
                }
                BAR_RAW();
                BAR_RAW();
            }

            }
        }
    }
}

DI void hgrn_scan(const Frame& F, int bh, int layer) {
    const int b = bh / 6, h = bh % 6, tid = F.tid, lane = F.lane, wave = F.wave, r = lane & 15, g = lane >> 4;
    LAS unsigned char* L = F.lds;
    constexpr int BUF = 18944, VB = 56832, OT = 81408;
    const unsigned char* hq = F.ws + WS_HQ + (size_t)bh * 128 * 8192; const unsigned char* hk = F.ws + WS_HK + (size_t)bh * 128 * 8192;
    const unsigned char* hv = F.ws + WS_HV + (size_t)bh * 128 * 8192; const unsigned char* ha = F.ws + WS_HA + (size_t)bh * 128 * 2048;
    const unsigned char* he = F.ws + WS_HE + (size_t)bh * 128 * 512;
    copy_g2l(L, hq, 8192, tid); copy_g2l(L + 8192, hk, 8192, tid); copy_g2l(L + 16384, ha, 2048, tid); copy_g2l(L + 18432, he, 512, tid); copy_g2l(L + VB, hv, 8192, tid);
    BAR_RAW();
    if (wave < 4) {
        f32x4 S[2][8];
#pragma unroll
        for (int n = 0; n < 2; ++n)
#pragma unroll
            for (int i = 0; i < 8; ++i) S[n][i] = (f32x4){0.f, 0.f, 0.f, 0.f};
        const int l16 = lane * 16;
#define HG_DMA(CK, BJ) do { const int ck_ = (CK); LAS unsigned char* Bd_ = L + (BJ) * BUF; LAS unsigned char* Vd_ = L + VB + (BJ) * 8192; const size_t o8_ = (size_t)ck_ * 8192 + (2 * wave) * 1024 + l16; \
        _Pragma("unroll") for (int i = 0; i < 2; ++i) { \
            __builtin_amdgcn_global_load_lds((const unsigned*)(hq + o8_ + i * 1024), (LAS unsigned*)(Bd_ + (2 * wave + i) * 1024), 16, 0, 0); \
            __builtin_amdgcn_global_load_lds((const unsigned*)(hk + o8_ + i * 1024), (LAS unsigned*)(Bd_ + 8192 + (2 * wave + i) * 1024), 16, 0, 0); \
            __builtin_amdgcn_global_load_lds((const unsigned*)(hv + o8_ + i * 1024), (LAS unsigned*)(Vd_ + (2 * wave + i) * 1024), 16, 0, 0); } \
        if (wave < 2) __builtin_amdgcn_global_load_lds((const unsigned*)(ha + (size_t)ck_ * 2048 + wave * 1024 + l16), (LAS unsigned*)(Bd_ + 16384 + wave * 1024), 16, 0, 0); \
        if (wave == 2 && lane < 32) __builtin_amdgcn_global_load_lds((const unsigned*)(he + (size_t)ck_ * 512 + l16), (LAS unsigned*)(Bd_ + 18432), 16, 0, 0); } while (0)
        HG_DMA(1, 1); HG_DMA(2, 2);
#pragma unroll 1
        for (int c3 = 0; c3 < 128; c3 += 3) {
        {
            const int ch = c3 + 0;
            LAS unsigned char* B0 = L + 0 * BUF;
            bf16x8 va[2];
            va[0] = *(const LAS bf16x8*)(L + VB + 0 * 8192 + (size_t)((2 * wave + 0) * 64 + lane) * 16); va[1] = *(const LAS bf16x8*)(L + VB + 0 * 8192 + (size_t)((2 * wave + 1) * 64 + lane) * 16);
            __builtin_amdgcn_sched_barrier(0);
            bf16x8 Sb[2][4];
#pragma unroll
            for (int n = 0; n < 2; ++n)
#pragma unroll
                for (int kb = 0; kb < 4; ++kb) Sb[n][kb] = pack_b(S[n][2 * kb], S[n][2 * kb + 1]);
            const LAS unsigned char* B0l = B0 + lane * 16;
            bf16x8 fq0[5], fq1[5]; f32x4 o[2][2];
            bf16x8 fk0[2], fk1[2]; f32x4 fe0[2], fe1[2];
            fq0[0] = *(const LAS bf16x8*)(B0l + 0*1024); fq0[1] = *(const LAS bf16x8*)(B0l + 1*1024); fq0[2] = *(const LAS bf16x8*)(B0l + 2*1024); fq0[3] = *(const LAS bf16x8*)(B0l + 3*1024); fq0[4] = *(const LAS bf16x8*)(B0l + 16384 + 0*1024);
            fq1[0] = *(const LAS bf16x8*)(B0l + 4*1024); fq1[1] = *(const LAS bf16x8*)(B0l + 5*1024); fq1[2] = *(const LAS bf16x8*)(B0l + 6*1024); fq1[3] = *(const LAS bf16x8*)(B0l + 7*1024); fq1[4] = *(const LAS bf16x8*)(B0l + 16384 + 1*1024);
            __builtin_amdgcn_sched_barrier(0);
            { f32x4 c0 = {0.f, 0.f, 0.f, 0.f}, c1 = {0.f, 0.f, 0.f, 0.f};
              c0 = MFMA16(fq0[0], Sb[0][0], c0); c1 = MFMA16(fq0[0], Sb[1][0], c1);
              c0 = MFMA16(fq0[1], Sb[0][1], c0); c1 = MFMA16(fq0[1], Sb[1][1], c1);
              c0 = MFMA16(fq0[2], Sb[0][2], c0); c1 = MFMA16(fq0[2], Sb[1][2], c1);
              c0 = MFMA16(fq0[3], Sb[0][3], c0); c1 = MFMA16(fq0[3], Sb[1][3], c1);
              o[0][0] = MFMA16(fq0[4], va[0], c0); o[1][0] = MFMA16(fq0[4], va[1], c1); }
            fk0[0] = *(const LAS bf16x8*)(B0l + 8192 + 0*1024); fe0[0] = *(const LAS f32x4*)(B0 + 18432 + (16 * 0 + 4 * g) * 4); fk0[1] = *(const LAS bf16x8*)(B0l + 8192 + 1*1024); fe0[1] = *(const LAS f32x4*)(B0 + 18432 + (16 * 1 + 4 * g) * 4);
            __builtin_amdgcn_sched_barrier(0);
            { f32x4 c0 = {0.f, 0.f, 0.f, 0.f}, c1 = {0.f, 0.f, 0.f, 0.f};
              c0 = MFMA16(fq1[0], Sb[0][0], c0); c1 = MFMA16(fq1[0], Sb[1][0], c1);
              c0 = MFMA16(fq1[1], Sb[0][1], c0); c1 = MFMA16(fq1[1], Sb[1][1], c1);
              c0 = MFMA16(fq1[2], Sb[0][2], c0); c1 = MFMA16(fq1[2], Sb[1][2], c1);
              c0 = MFMA16(fq1[3], Sb[0][3], c0); c1 = MFMA16(fq1[3], Sb[1][3], c1);
              o[0][1] = MFMA16(fq1[4], va[0], c0); o[1][1] = MFMA16(fq1[4], va[1], c1); }
            fk1[0] = *(const LAS bf16x8*)(B0l + 8192 + 2*1024); fe1[0] = *(const LAS f32x4*)(B0 + 18432 + (16 * 2 + 4 * g) * 4); fk1[1] = *(const LAS bf16x8*)(B0l + 8192 + 3*1024); fe1[1] = *(const LAS f32x4*)(B0 + 18432 + (16 * 3 + 4 * g) * 4);
            __builtin_amdgcn_sched_barrier(0);
            S[0][0] = MFMA16(fk0[0], va[0], S[0][0] * fe0[0]); S[1][0] = MFMA16(fk0[0], va[1], S[1][0] * fe0[0]);
            S[0][1] = MFMA16(fk0[1], va[0], S[0][1] * fe0[1]); S[1][1] = MFMA16(fk0[1], va[1], S[1][1] * fe0[1]);
            __builtin_amdgcn_sched_barrier(0);
            fk0[0] = *(const LAS bf16x8*)(B0l + 8192 + 4*1024); fe0[0] = *(const LAS f32x4*)(B0 + 18432 + (16 * 4 + 4 * g) * 4); fk0[1] = *(const LAS bf16x8*)(B0l + 8192 + 5*1024); fe0[1] = *(const LAS f32x4*)(B0 + 18432 + (16 * 5 + 4 * g) * 4);
            __builtin_amdgcn_sched_barrier(0);
            S[0][2] = MFMA16(fk1[0], va[0], S[0][2] * fe1[0]); S[1][2] = MFMA16(fk1[0], va[1], S[1][2] * fe1[0]);
            S[0][3] = MFMA16(fk1[1], va[0], S[0][3] * fe1[1]); S[1][3] = MFMA16(fk1[1], va[1], S[1][3] * fe1[1]);
            __builtin_amdgcn_sched_barrier(0);
            fk1[0] = *(const LAS bf16x8*)(B0l + 8192 + 6*1024); fe1[0] = *(const LAS f32x4*)(B0 + 18432 + (16 * 6 + 4 * g) * 4); fk1[1] = *(const LAS bf16x8*)(B0l + 8192 + 7*1024); fe1[1] = *(const LAS f32x4*)(B0 + 18432 + (16 * 7 + 4 * g) * 4);
            __builtin_amdgcn_sched_barrier(0);
            S[0][4] = MFMA16(fk0[0], va[0], S[0][4] * fe0[0]); S[1][4] = MFMA16(fk0[0], va[1], S[1][4] * fe0[0]);
            S[0][5] = MFMA16(fk0[1], va[0], S[0][5] * fe0[1]); S[1][5] = MFMA16(fk0[1], va[1], S[1][5] * fe0[1]);
            __builtin_amdgcn_sched_barrier(0);
            __builtin_amdgcn_sched_barrier(0);
            S[0][6] = MFMA16(fk1[0], va[0], S[0][6] * fe1[0]); S[1][6] = MFMA16(fk1[0], va[1], S[1][6] * fe1[0]);
            S[0][7] = MFMA16(fk1[1], va[0], S[0][7] * fe1[1]); S[1][7] = MFMA16(fk1[1], va[1], S[1][7] * fe1[1]);
            __builtin_amdgcn_sched_barrier(0);
            BAR_RAW();
#pragma unroll
            for (int n = 0; n < 2; ++n)
#pragma unroll
                for (int mt = 0; mt < 2; ++mt)
#pragma unroll
                    for (int e = 0; e < 4; ++e) ((LAS float*)(L + OT))[(16 * mt + 4 * g + e) * 132 + 32 * wave + 16 * n + r] = o[n][mt][e];
            if (ch + 2 < 128) { if (wave < 3) asm volatile("s_waitcnt vmcnt(7)" ::: "memory"); else asm volatile("s_waitcnt vmcnt(6)" ::: "memory"); }
            else asm volatile("s_waitcnt vmcnt(0)" ::: "memory");
            BAR_RAW();
            if (ch + 3 < 128) HG_DMA(ch + 3, 0);
        }

            if (c3 + 1 >= 128) break;
        {
            const int ch = c3 + 1;
            LAS unsigned char* B0 = L + 1 * BUF;
            bf16x8 va[2];
            va[0] = *(const LAS bf16x8*)(L + VB + 1 * 8192 + (size_t)((2 * wave + 0) * 64 + lane) * 16); va[1] = *(const LAS bf16x8*)(L + VB + 1 * 8192 + (size_t)((2 * wave + 1) * 64 + lane) * 16);
            __builtin_amdgcn_sched_barrier(0);
            bf16x8 Sb[2][4];
#pragma unroll
            for (int n = 0; n < 2; ++n)
#pragma unroll
                for (int kb = 0; kb < 4; ++kb) Sb[n][kb] = pack_b(S[n][2 * kb], S[n][2 * kb + 1]);
            const LAS unsigned char* B0l = B0 + lane * 16;
            bf16x8 fq0[5], fq1[5]; f32x4 o[2][2];
            bf16x8 fk0[2], fk1[2]; f32x4 fe0[2], fe1[2];
            fq0[0] = *(const LAS bf16x8*)(B0l + 0*1024); fq0[1] = *(const LAS bf16x8*)(B0l + 1*1024); fq0[2] = *(const LAS bf16x8*)(B0l + 2*1024); fq0[3] = *(const LAS bf16x8*)(B0l + 3*1024); fq0[4] = *(const LAS bf16x8*)(B0l + 16384 + 0*1024);
            fq1[0] = *(const LAS bf16x8*)(B0l + 4*1024); fq1[1] = *(const LAS bf16x8*)(B0l + 5*1024); fq1[2] = *(const LAS bf16x8*)(B0l + 6*1024); fq1[3] = *(const LAS bf16x8*)(B0l + 7*1024); fq1[4] = *(const LAS bf16x8*)(B0l + 16384 + 1*1024);
            __builtin_amdgcn_sched_barrier(0);
            { f32x4 c0 = {0.f, 0.f, 0.f, 0.f}, c1 = {0.f, 0.f, 0.f, 0.f};
              c0 = MFMA16(fq0[0], Sb[0][0], c0); c1 = MFMA16(fq0[0], Sb[1][0], c1);
              c0 = MFMA16(fq0[1], Sb[0][1], c0); c1 = MFMA16(fq0[1], Sb[1][1], c1);
              c0 = MFMA16(fq0[2], Sb[0][2], c0); c1 = MFMA16(fq0[2], Sb[1][2], c1);
              c0 = MFMA16(fq0[3], Sb[0][3], c0); c1 = MFMA16(fq0[3], Sb[1][3], c1);
              o[0][0] = MFMA16(fq0[4], va[0], c0); o[1][0] = MFMA16(fq0[4], va[1], c1); }
            fk0[0] = *(const LAS bf16x8*)(B0l + 8192 + 0*1024); fe0[0] = *(const LAS f32x4*)(B0 + 18432 + (16 * 0 + 4 * g) * 4); fk0[1] = *(const LAS bf16x8*)(B0l + 8192 + 1*1024); fe0[1] = *(const LAS f32x4*)(B0 + 18432 + (16 * 1 + 4 * g) * 4);
            __builtin_amdgcn_sched_barrier(0);
            { f32x4 c0 = {0.f, 0.f, 0.f, 0.f}, c1 = {0.f, 0.f, 0.f, 0.f};
              c0 = MFMA16(fq1[0], Sb[0][0], c0); c1 = MFMA16(fq1[0], Sb[1][0], c1);
              c0 = MFMA16(fq1[1], Sb[0][1], c0); c1 = MFMA16(fq1[1], Sb[1][1], c1);
              c0 = MFMA16(fq1[2], Sb[0][2], c0); c1 = MFMA16(fq1[2], Sb[1][2], c1);
              c0 = MFMA16(fq1[3], Sb[0][3], c0); c1 = MFMA16(fq1[3], Sb[1][3], c1);
              o[0][1] = MFMA16(fq1[4], va[0], c0); o[1][1] = MFMA16(fq1[4], va[1], c1); }
            fk1[0] = *(const LAS bf16x8*)(B0l + 8192 + 2*1024); fe1[0] = *(const LAS f32x4*)(B0 + 18432 + (16 * 2 + 4 * g) * 4); fk1[1] = *(const LAS bf16x8*)(B0l + 8192 + 3*1024); fe1[1] = *(const LAS f32x4*)(B0 + 18432 + (16 * 3 + 4 * g) * 4);
            __builtin_amdgcn_sched_barrier(0);
            S[0][0] = MFMA16(fk0[0], va[0], S[0][0] * fe0[0]); S[1][0] = MFMA16(fk0[0], va[1], S[1][0] * fe0[0]);
            S[0][1] = MFMA16(fk0[1], va[0], S[0][1] * fe0[1]); S[1][1] = MFMA16(fk0[1], va[1], S[1][1] * fe0[1]);
            __builtin_amdgcn_sched_barrier(0);
            fk0[0] = *(const LAS bf16x8*)(B0l + 8192 + 4*1024); fe0[0] = *(const LAS f32x4*)(B0 + 18432 + (16 * 4 + 4 * g) * 4); fk0[1] = *(const LAS bf16x8*)(B0l + 8192 + 5*1024); fe0[1] = *(const LAS f32x4*)(B0 + 18432 + (16 * 5 + 4 * g) * 4);
            __builtin_amdgcn_sched_barrier(0);
            S[0][2] = MFMA16(fk1[0], va[0], S[0][2] * fe1[0]); S[1][2] = MFMA16(fk1[0], va[1], S[1][2] * fe1[0]);
            S[0][3] = MFMA16(fk1[1], va[0], S[0][3] * fe1[1]); S[1][3] = MFMA16(fk1[1], va[1], S[1][3] * fe1[1]);
            __builtin_amdgcn_sched_barrier(0);
            fk1[0] = *(const LAS bf16x8*)(B0l + 8192 + 6*1024); fe1[0] = *(const LAS f32x4*)(B0 + 18432 + (16 * 6 + 4 * g) * 4); fk1[1] = *(const LAS bf16x8*)(B0l + 8192 + 7*1024); fe1[1] = *(const LAS f32x4*)(B0 + 18432 + (16 * 7 + 4 * g) * 4);
            __builtin_amdgcn_sched_barrier(0);
            S[0][4] = MFMA16(fk0[0], va[0], S[0][4] * fe0[0]); S[1][4] = MFMA16(fk0[0], va[1], S[1][4] * fe0[0]);
            S[0][5] = MFMA16(fk0[1], va[0], S[0][5] * fe0[1]); S[1][5] = MFMA16(fk0[1], va[1], S[1][5] * fe0[1]);
            __builtin_amdgcn_sched_barrier(0);
            __builtin_amdgcn_sched_barrier(0);
            S[0][6] = MFMA16(fk1[0], va[0], S[0][6] * fe1[0]); S[1][6] = MFMA16(fk1[0], va[1], S[1][6] * fe1[0]);
            S[0][7] = MFMA16(fk1[1], va[0], S[0][7] * fe1[1]); S[1][7] = MFMA16(fk1[1], va[1], S[1][7] * fe1[1]);
            __builtin_amdgcn_sched_barrier(0);
            BAR_RAW();
#pragma unroll
            for (int n = 0; n < 2; ++n)
#pragma unroll
                for (int mt = 0; mt < 2; ++mt)
#pragma unroll
                    for (int e = 0; e < 4; ++e) ((LAS float*)(L + OT))[(16 * mt + 4 * g + e) * 132 + 32 * wave + 16 * n + r] = o[n][mt][e];
            if (ch + 2 < 128) { if (wave < 3) asm volatile("s_waitcnt vmcnt(7)" ::: "memory"); else asm volatile("s_waitcnt vmcnt(6)" ::: "memory"); }
            else asm volatile("s_waitcnt vmcnt(0)" ::: "memory");
            BAR_RAW();
            if (ch + 3 < 128) HG_DMA(ch + 3, 1);
        }

            if (c3 + 2 >= 128) break;
        {
            const int ch = c3 + 2;
            LAS unsigned char* B0 = L + 2 * BUF;
            bf16x8 va[2];
            va[0] = *(const LAS bf16x8*)(L + VB + 2 * 8192 + (size_t)((2 * wave + 0) * 64 + lane) * 16); va[1] = *(const LAS bf16x8*)(L + VB + 2 * 8192 + (size_t)((2 * wave + 1) * 64 + lane) * 16);
            __builtin_amdgcn_sched_barrier(0);
            bf16x8 Sb[2][4];
#pragma unroll
            for (int n = 0; n < 2; ++n)
#pragma unroll
                for (int kb = 0; kb < 4; ++kb) Sb[n][kb] = pack_b(S[n][2 * kb], S[n][2 * kb + 1]);
            const LAS unsigned char* B0l = B0 + lane * 16;
            bf16x8 fq0[5], fq1[5]; f32x4 o[2][2];
            bf16x8 fk0[2], fk1[2]; f32x4 fe0[2], fe1[2];
            fq0[0] = *(const LAS bf16x8*)(B0l + 0*1024); fq0[1] = *(const LAS bf16x8*)(B0l + 1*1024); fq0[2] = *(const LAS bf16x8*)(B0l + 2*1024); fq0[3] = *(const LAS bf16x8*)(B0l + 3*1024); fq0[4] = *(const LAS bf16x8*)(B0l + 16384 + 0*1024);
            fq1[0] = *(const LAS bf16x8*)(B0l + 4*1024); fq1[1] = *(const LAS bf16x8*)(B0l + 5*1024); fq1[2] = *(const LAS bf16x8*)(B0l + 6*1024); fq1[3] = *(const LAS bf16x8*)(B0l + 7*1024); fq1[4] = *(const LAS bf16x8*)(B0l + 16384 + 1*1024);
            __builtin_amdgcn_sched_barrier(0);
            { f32x4 c0 = {0.f, 0.f, 0.f, 0.f}, c1 = {0.f, 0.f, 0.f, 0.f};
              c0 = MFMA16(fq0[0], Sb[0][0], c0); c1 = MFMA16(fq0[0], Sb[1][0], c1);
              c0 = MFMA16(fq0[1], Sb[0][1], c0); c1 = MFMA16(fq0[1], Sb[1][1], c1);
              c0 = MFMA16(fq0[2], Sb[0][2], c0); c1 = MFMA16(fq0[2], Sb[1][2], c1);
              c0 = MFMA16(fq0[3], Sb[0][3], c0); c1 = MFMA16(fq0[3], Sb[1][3], c1);
              o[0][0] = MFMA16(fq0[4], va[0], c0); o[1][0] = MFMA16(fq0[4], va[1], c1); }
            fk0[0] = *(const LAS bf16x8*)(B0l + 8192 + 0*1024); fe0[0] = *(const LAS f32x4*)(B0 + 18432 + (16 * 0 + 4 * g) * 4); fk0[1] = *(const LAS bf16x8*)(B0l + 8192 + 1*1024); fe0[1] = *(const LAS f32x4*)(B0 + 18432 + (16 * 1 + 4 * g) * 4);
            __builtin_amdgcn_sched_barrier(0);
            { f32x4 c0 = {0.f, 0.f, 0.f, 0.f}, c1 = {0.f, 0.f, 0.f, 0.f};
              c0 = MFMA16(fq1[0], Sb[0][0], c0); c1 = MFMA16(fq1[0], Sb[1][0], c1);
              c0 = MFMA16(fq1[1], Sb[0][1], c0); c1 = MFMA16(fq1[1], Sb[1][1], c1);
              c0 = MFMA16(fq1[2], Sb[0][2], c0); c1 = MFMA16(fq1[2], Sb[1][2], c1);
              c0 = MFMA16(fq1[3], Sb[0][3], c0); c1 = MFMA16(fq1[3], Sb[1][3], c1);
              o[0][1] = MFMA16(fq1[4], va[0], c0); o[1][1] = MFMA16(fq1[4], va[1], c1); }
            fk1[0] = *(const LAS bf16x8*)(B0l + 8192 + 2*1024); fe1[0] = *(const LAS f32x4*)(B0 + 18432 + (16 * 2 + 4 * g) * 4); fk1[1] = *(const LAS bf16x8*)(B0l + 8192 + 3*1024); fe1[1] = *(const LAS f32x4*)(B0 + 18432 + (16 * 3 + 4 * g) * 4);
            __builtin_amdgcn_sched_barrier(0);
            S[0][0] = MFMA16(fk0[0], va[0], S[0][0] * fe0[0]); S[1][0] = MFMA16(fk0[0], va[1], S[1][0] * fe0[0]);
            S[0][1] = MFMA16(fk0[1], va[0], S[0][1] * fe0[1]); S[1][1] = MFMA16(fk0[1], va[1], S[1][1] * fe0[1]);
            __builtin_amdgcn_sched_barrier(0);
            fk0[0] = *(const LAS bf16x8*)(B0l + 8192 + 4*1024); fe0[0] = *(const LAS f32x4*)(B0 + 18432 + (16 * 4 + 4 * g) * 4); fk0[1] = *(const LAS bf16x8*)(B0l + 8192 + 5*1024); fe0[1] = *(const LAS f32x4*)(B0 + 18432 + (16 * 5 + 4 * g) * 4);
            __builtin_amdgcn_sched_barrier(0);
            S[0][2] = MFMA16(fk1[0], va[0], S[0][2] * fe1[0]); S[1][2] = MFMA16(fk1[0], va[1], S[1][2] * fe1[0]);
            S[0][3] = MFMA16(fk1[1], va[0], S[0][3] * fe1[1]); S[1][3] = MFMA16(fk1[1], va[1], S[1][3] * fe1[1]);
            __builtin_amdgcn_sched_barrier(0);
            fk1[0] = *(const LAS bf16x8*)(B0l + 8192 + 6*1024); fe1[0] = *(const LAS f32x4*)(B0 + 18432 + (16 * 6 + 4 * g) * 4); fk1[1] = *(const LAS bf16x8*)(B0l + 8192 + 7*1024); fe1[1] = *(const LAS f32x4*)(B0 + 18432 + (16 * 7 + 4 * g) * 4);
            __builtin_amdgcn_sched_barrier(0);
            S[0][4] = MFMA16(fk0[0], va[0], S[0][4] * fe0[0]); S[1][4] = MFMA16(fk0[0], va[1], S[1][4] * fe0[0]);
            S[0][5] = MFMA16(fk0[1], va[0], S[0][5] * fe0[1]); S[1][5] = MFMA16(fk0[1], va[1], S[1][5] * fe0[1]);
            __builtin_amdgcn_sched_barrier(0);
            __builtin_amdgcn_sched_barrier(0);
            S[0][6] = MFMA16(fk1[0], va[0], S[0][6] * fe1[0]); S[1][6] = MFMA16(fk1[0], va[1], S[1][6] * fe1[0]);
            S[0][7] = MFMA16(fk1[1], va[0], S[0][7] * fe1[1]); S[1][7] = MFMA16(fk1[1], va[1], S[1][7] * fe1[1]);
            __builtin_amdgcn_sched_barrier(0);
            BAR_RAW();
#pragma unroll
            for (int n = 0; n < 2; ++n)
#pragma unroll
                for (int mt = 0; mt < 2; ++mt)
#pragma unroll
                    for (int e = 0; e < 4; ++e) ((LAS float*)(L + OT))[(16 * mt + 4 * g + e) * 132 + 32 * wave + 16 * n + r] = o[n][mt][e];
            if (ch + 2 < 128) { if (wave < 3) asm volatile("s_waitcnt vmcnt(7)" ::: "memory"); else asm volatile("s_waitcnt vmcnt(6)" ::: "memory"); }
            else asm volatile("s_waitcnt vmcnt(0)" ::: "memory");
            BAR_RAW();
            if (ch + 3 < 128) HG_DMA(ch + 3, 2);
        }
        }
#undef HG_DMA
        BAR_RAW(); BAR_RAW();
    } else {
        const int ht = tid - 256, nt_t = ht >> 3, nt_c0 = 16 * (ht & 7);
        const bf16* P = (const bf16*)(F.ws + WS_P); bf16* MIX = (bf16*)(F.ws + WS_MIX);
        const float* gain = F.in[14] + layer * 128 + nt_c0;
        f32x4 gn[4];
#pragma unroll
        for (int q4 = 0; q4 < 4; ++q4) gn[q4] = *(const GAS f32x4*)(gain + 4 * q4);
        const bf16* zbase = P + ((size_t)b * SEQ + nt_t) * NP + PB_G + h * 128 + nt_c0;
        v4u za[2] = {(v4u){0u, 0u, 0u, 0u}, (v4u){0u, 0u, 0u, 0u}}, zb[2] = {(v4u){0u, 0u, 0u, 0u}, (v4u){0u, 0u, 0u, 0u}};
#pragma unroll 1
        for (int c2 = 0; c2 < 130; c2 += 2) {
        {
            const int ch = c2;
            const int cz = (ch < 128) ? ch : 127;
            zb[0] = *(const GAS v4u*)(zbase + (size_t)cz * 32 * NP); zb[1] = *(const GAS v4u*)(zbase + (size_t)cz * 32 * NP + 8);
            __builtin_amdgcn_sched_barrier(0);
            if (ch > 0) {
                const size_t m = (size_t)b * SEQ + (ch - 1) * 32 + nt_t;
                const LAS float* op = (const LAS float*)(L + OT) + nt_t * 132 + nt_c0;
                f32x4 x[4]; float ss = 0.f;
#pragma unroll
                for (int q4 = 0; q4 < 4; ++q4) { x[q4] = *(const LAS f32x4*)(op + 4 * q4); ss += (x[q4].x * x[q4].x + x[q4].y * x[q4].y) + (x[q4].z * x[q4].z + x[q4].w * x[q4].w); }
                ss += __shfl_xor(ss, 1); ss += __shfl_xor(ss, 2); ss += __shfl_xor(ss, 4);
                const float rs = frsq(ss * (1.f / 128.f) + EPS);
                bf16* mp = MIX + m * D + MIX_B + h * 128 + nt_c0;
#pragma unroll
                for (int i = 0; i < 2; ++i) {
                    const f32x4 xa = x[2 * i] * rs * gn[2 * i], xb = x[2 * i + 1] * rs * gn[2 * i + 1];
                    v4u w;
                    w.x = pk2(xa.x * silu(bflo(za[i].x)), xa.y * silu(bfhi(za[i].x))); w.y = pk2(xa.z * silu(bflo(za[i].y)), xa.w * silu(bfhi(za[i].y)));
                    w.z = pk2(xb.x * silu(bflo(za[i].z)), xb.y * silu(bfhi(za[i].z))); w.w = pk2(xb.z * silu(bflo(za[i].w)), xb.w * silu(bfhi(za[i].w)));
                    *(GAS v4u*)(mp + 8 * i) = w;
                }
            }
            BAR_RAW();
            BAR_RAW();
        }

            if (c2 + 1 > 128) break;
        {
            const int ch = c2 + 1;
            const int cz = (ch < 128) ? ch : 127;
            za[0] = *(const GAS v4u*)(zbase + (size_t)cz * 32 * NP); za[1] = *(const GAS v4u*)(zbase + (size_t)cz * 32 * NP + 8);
            __builtin_amdgcn_sched_barrier(0);
            if (ch > 0) {
                const size_t m = (size_t)b * SEQ + (ch - 1) * 32 + nt_t;
                const LAS float* op = (const LAS float*)(L + OT) + nt_t * 132 + nt_c0;
                f32x4 x[4]; float ss = 0.f;
#pragma unroll
                for (int q4 = 0; q4 < 4; ++q4) { x[q4] = *(const LAS f32x4*)(op + 4 * q4); ss += (x[q4].x * x[q4].x + x[q4].y * x[q4].y) + (x[q4].z * x[q4].z + x[q4].w * x[q4].w); }
                ss += __shfl_xor(ss, 1); ss += __shfl_xor(ss, 2); ss += __shfl_xor(ss, 4);
                const float rs = frsq(ss * (1.f / 128.f) + EPS);
                bf16* mp = MIX + m * D + MIX_B + h * 128 + nt_c0;
#pragma unroll
                for (int i = 0; i < 2; ++i) {
                    const f32x4 xa = x[2 * i] * rs * gn[2 * i], xb = x[2 * i + 1] * rs * gn[2 * i + 1];
                    v4u w;
                    w.x = pk2(xa.x * silu(bflo(zb[i].x)), xa.y * silu(bfhi(zb[i].x))); w.y = pk2(xa.z * silu(bflo(zb[i].y)), xa.w * silu(bfhi(zb[i].y)));
                    w.z = pk2(xb.x * silu(bflo(zb[i].z)), xb.y * silu(bfhi(zb[i].z))); w.w = pk2(xb.z * silu(bflo(zb[i].w)), xb.w * silu(bfhi(zb[i].w)));
                    *(GAS v4u*)(mp + 8 * i) = w;
                }
            }
            BAR_RAW();
            BAR_RAW();
        }

        }
    }
}
#ifndef BAR_LDS
#define BAR_LDS() do { asm volatile("s_waitcnt lgkmcnt(0)" ::: "memory"); __builtin_amdgcn_s_barrier(); asm volatile("" ::: "memory"); } while (0)
#endif
#define MFMA32(a, b, c) __builtin_amdgcn_mfma_f32_32x32x16_bf16((a), (b), (c), 0, 0, 0)
DI int crow32(int reg, int hh) { return (reg & 3) + 8 * (reg >> 2) + 4 * hh; }
DI void attn_unit(const Frame& F, int bh, int qi, int layer) {
    const int b = bh >> 2, h = bh & 3, tid = F.tid, lane = F.lane, wave = F.wave, c = wave >> 2, qs = wave & 3, r32 = lane & 31, hh = lane >> 5;
    LAS unsigned char* L = F.lds;
    constexpr int BUF = 32768, CB = 65536;
    const unsigned char* kf0 = F.ws + WS_KF + ((size_t)bh * 2 + 0) * 64 * 8192; const unsigned char* kf1 = F.ws + WS_KF + ((size_t)bh * 2 + 1) * 64 * 8192;
    const unsigned char* vf = F.ws + WS_VF + (size_t)bh * 64 * 16384;
    const int tq = 128 * qi + 32 * qs + r32;
    const int tw0 = 128 * qi + 32 * qs;
    bf16x8 qf[4];
    {
        const bf16* q = (const bf16*)(F.ws + WS_QR) + (((size_t)bh * 2 + c) * SEQ + tq) * 64 + 8 * hh;
#pragma unroll
        for (int s = 0; s < 4; ++s) qf[s] = *(const GAS bf16x8*)(q + 16 * s);
    }
#pragma unroll
    for (int s = 0; s < 4; ++s) asm volatile("" : "+v"(qf[s]));
    f32x16 O[4];
#pragma unroll
    for (int i = 0; i < 4; ++i)
#pragma unroll
        for (int e = 0; e < 16; ++e) O[i][e] = 0.f;
    float mrun = -__builtin_inff(), lrun = 0.f;
    const int ntile = 2 * qi + 2;
    v4u pa[4], pb4[4];
    {
        const int o = tid * 16;
        pa[0] = *(const GAS v4u*)(kf0 + o); pa[1] = *(const GAS v4u*)(kf1 + o); pa[2] = *(const GAS v4u*)(vf + o); pa[3] = *(const GAS v4u*)(vf + 8192 + o);
        pb4[0] = *(const GAS v4u*)(kf0 + 8192 + o); pb4[1] = *(const GAS v4u*)(kf1 + 8192 + o); pb4[2] = *(const GAS v4u*)(vf + 16384 + o); pb4[3] = *(const GAS v4u*)(vf + 16384 + 8192 + o);
        *(LAS v4u*)(L + o) = pa[0]; *(LAS v4u*)(L + 8192 + o) = pa[1]; *(LAS v4u*)(L + 16384 + o) = pa[2]; *(LAS v4u*)(L + 24576 + o) = pa[3];
    }
    BAR_LDS();
#pragma unroll 1
    for (int j2i = 0; j2i < ntile; j2i += 2) {
        {
        const int j = j2i;
        LAS unsigned char* B0 = L + (j & 1) * BUF; LAS unsigned char* B1 = L + ((j + 1) & 1) * BUF;
        {
            const int j2 = (j + 2 < ntile) ? j + 2 : ntile - 1;
            const size_t o = (size_t)tid * 16;
            pa[0] = *(const GAS v4u*)(kf0 + (size_t)j2 * 8192 + o); pa[1] = *(const GAS v4u*)(kf1 + (size_t)j2 * 8192 + o);
            pa[2] = *(const GAS v4u*)(vf + (size_t)j2 * 16384 + o); pa[3] = *(const GAS v4u*)(vf + (size_t)j2 * 16384 + 8192 + o);
        }
        __builtin_amdgcn_sched_barrier(0);
        const int k0 = 64 * j;
        if (k0 <= tw0 + 31) {
            f32x16 St[2];
            const LAS unsigned char* Bl = B0 + lane * 16;
            bf16x8 kf[8];
#pragma unroll
            for (int i = 0; i < 8; ++i) kf[i] = *(const LAS bf16x8*)(Bl + c * 8192 + i * 1024);
            __builtin_amdgcn_sched_barrier(0);
#pragma unroll
            for (int kb = 0; kb < 2; ++kb) {
#pragma unroll
                for (int e = 0; e < 16; ++e) St[kb][e] = 0.f;
#pragma unroll
                for (int s = 0; s < 4; ++s) St[kb] = MFMA32(kf[kb * 4 + s], qf[s], St[kb]);
            }
            bf16x8 vf0[8], vf1[8];
#pragma unroll
            for (int i = 0; i < 8; ++i) vf0[i] = *(const LAS bf16x8*)(Bl + 16384 + i * 1024);
            __builtin_amdgcn_sched_barrier(0);
            if (k0 + 63 > tw0) {
#pragma unroll
                for (int kb = 0; kb < 2; ++kb)
#pragma unroll
                    for (int e = 0; e < 16; ++e) { const int key = k0 + 32 * kb + crow32(e, hh); if (key > tq) St[kb][e] = -__builtin_inff(); }
            }
            float mx = St[0][0];
#pragma unroll
            for (int kb = 0; kb < 2; ++kb)
#pragma unroll
                for (int e = 0; e < 16; ++e) mx = fmaxf(mx, St[kb][e]);
            mx = fmaxf(mx, __shfl_xor(mx, 32));
            const float mnew = fmaxf(mrun, mx);
            const float alpha = fexp2(mrun - mnew);
            mrun = mnew;
            float ps = 0.f;
#pragma unroll
            for (int kb = 0; kb < 2; ++kb)
#pragma unroll
                for (int e = 0; e < 16; ++e) { const float p = fexp2(St[kb][e] - mnew); St[kb][e] = p; ps += p; }
            lrun = lrun * alpha + ps;
#pragma unroll
            for (int i = 0; i < 4; ++i)
#pragma unroll
                for (int e = 0; e < 16; ++e) O[i][e] *= alpha;
            bf16x8 pb[2][2];
#pragma unroll
            for (int kb = 0; kb < 2; ++kb)
#pragma unroll
                for (int s = 0; s < 2; ++s) { v4u w; w.x = pk2(St[kb][8 * s], St[kb][8 * s + 1]); w.y = pk2(St[kb][8 * s + 2], St[kb][8 * s + 3]); w.z = pk2(St[kb][8 * s + 4], St[kb][8 * s + 5]); w.w = pk2(St[kb][8 * s + 6], St[kb][8 * s + 7]);
                    pb[kb][s] = __builtin_bit_cast(bf16x8, w); }
#pragma unroll
            for (int i = 0; i < 8; ++i) vf1[i] = *(const LAS bf16x8*)(Bl + 16384 + (8 + i) * 1024);
            __builtin_amdgcn_sched_barrier(0);
#pragma unroll
            for (int dvb = 0; dvb < 2; ++dvb)
#pragma unroll
                for (int kb = 0; kb < 2; ++kb)
#pragma unroll
                    for (int s = 0; s < 2; ++s) O[dvb] = MFMA32(vf0[(dvb * 2 + kb) * 2 + s], pb[kb][s], O[dvb]);
            __builtin_amdgcn_sched_barrier(0);
#pragma unroll
            for (int dvb = 0; dvb < 2; ++dvb)
#pragma unroll
                for (int kb = 0; kb < 2; ++kb)
#pragma unroll
                    for (int s = 0; s < 2; ++s) O[2 + dvb] = MFMA32(vf1[(dvb * 2 + kb) * 2 + s], pb[kb][s], O[2 + dvb]);
        }
        if (j + 1 < ntile) {
            const int o = tid * 16;
            *(LAS v4u*)(B1 + o) = pb4[0]; *(LAS v4u*)(B1 + 8192 + o) = pb4[1]; *(LAS v4u*)(B1 + 16384 + o) = pb4[2]; *(LAS v4u*)(B1 + 24576 + o) = pb4[3];
        }
        BAR_LDS();
        }

        {
        const int j = j2i + 1;
        LAS unsigned char* B0 = L + (j & 1) * BUF; LAS unsigned char* B1 = L + ((j + 1) & 1) * BUF;
        {
            const int j2 = (j + 2 < ntile) ? j + 2 : ntile - 1;
            const size_t o = (size_t)tid * 16;
            pb4[0] = *(const GAS v4u*)(kf0 + (size_t)j2 * 8192 + o); pb4[1] = *(const GAS v4u*)(kf1 + (size_t)j2 * 8192 + o);
            pb4[2] = *(const GAS v4u*)(vf + (size_t)j2 * 16384 + o); pb4[3] = *(const GAS v4u*)(vf + (size_t)j2 * 16384 + 8192 + o);
        }
        __builtin_amdgcn_sched_barrier(0);
        const int k0 = 64 * j;
        if (k0 <= tw0 + 31) {
            f32x16 St[2];
            const LAS unsigned char* Bl = B0 + lane * 16;
            bf16x8 kf[8];
#pragma unroll
            for (int i = 0; i < 8; ++i) kf[i] = *(const LAS bf16x8*)(Bl + c * 8192 + i * 1024);
            __builtin_amdgcn_sched_barrier(0);
#pragma unroll
            for (int kb = 0; kb < 2; ++kb) {
#pragma unroll
                for (int e = 0; e < 16; ++e) St[kb][e] = 0.f;
#pragma unroll
                for (int s = 0; s < 4; ++s) St[kb] = MFMA32(kf[kb * 4 + s], qf[s], St[kb]);
            }
            bf16x8 vf0[8], vf1[8];
#pragma unroll
            for (int i = 0; i < 8; ++i) vf0[i] = *(const LAS bf16x8*)(Bl + 16384 + i * 1024);
            __builtin_amdgcn_sched_barrier(0);
            if (k0 + 63 > tw0) {
#pragma unroll
                for (int kb = 0; kb < 2; ++kb)
#pragma unroll
                    for (int e = 0; e < 16; ++e) { const int key = k0 + 32 * kb + crow32(e, hh); if (key > tq) St[kb][e] = -__builtin_inff(); }
            }
            float mx = St[0][0];
#pragma unroll
            for (int kb = 0; kb < 2; ++kb)
#pragma unroll
                for (int e = 0; e < 16; ++e) mx = fmaxf(mx, St[kb][e]);
            mx = fmaxf(mx, __shfl_xor(mx, 32));
            const float mnew = fmaxf(mrun, mx);
            const float alpha = fexp2(mrun - mnew);
            mrun = mnew;
            float ps = 0.f;
#pragma unroll
            for (int kb = 0; kb < 2; ++kb)
#pragma unroll
                for (int e = 0; e < 16; ++e) { const float p = fexp2(St[kb][e] - mnew); St[kb][e] = p; ps += p; }
            lrun = lrun * alpha + ps;
#pragma unroll
            for (int i = 0; i < 4; ++i)
#pragma unroll
                for (int e = 0; e < 16; ++e) O[i][e] *= alpha;
            bf16x8 pb[2][2];
#pragma unroll
            for (int kb = 0; kb < 2; ++kb)
#pragma unroll
                for (int s = 0; s < 2; ++s) { v4u w; w.x = pk2(St[kb][8 * s], St[kb][8 * s + 1]); w.y = pk2(St[kb][8 * s + 2], St[kb][8 * s + 3]); w.z = pk2(St[kb][8 * s + 4], St[kb][8 * s + 5]); w.w = pk2(St[kb][8 * s + 6], St[kb][8 * s + 7]);
                    pb[kb][s] = __builtin_bit_cast(bf16x8, w); }
#pragma unroll
            for (int i = 0; i < 8; ++i) vf1[i] = *(const LAS bf16x8*)(Bl + 16384 + (8 + i) * 1024);
            __builtin_amdgcn_sched_barrier(0);
#pragma unroll
            for (int dvb = 0; dvb < 2; ++dvb)
#pragma unroll
                for (int kb = 0; kb < 2; ++kb)
#pragma unroll
                    for (int s = 0; s < 2; ++s) O[dvb] = MFMA32(vf0[(dvb * 2 + kb) * 2 + s], pb[kb][s], O[dvb]);
            __builtin_amdgcn_sched_barrier(0);
#pragma unroll
            for (int dvb = 0; dvb < 2; ++dvb)
#pragma unroll
                for (int kb = 0; kb < 2; ++kb)
#pragma unroll
                    for (int s = 0; s < 2; ++s) O[2 + dvb] = MFMA32(vf1[(dvb * 2 + kb) * 2 + s], pb[kb][s], O[2 + dvb]);
        }
        if (j + 1 < ntile) {
            const int o = tid * 16;
            *(LAS v4u*)(B1 + o) = pa[0]; *(LAS v4u*)(B1 + 8192 + o) = pa[1]; *(LAS v4u*)(B1 + 16384 + o) = pa[2]; *(LAS v4u*)(B1 + 24576 + o) = pa[3];
        }
        BAR_LDS();
        }

    }
    lrun += __shfl_xor(lrun, 32);
    const float* lamp = (const float*)(F.ws + WS_LBS + 16384);
    const float lam = lamp[2 * layer], li = lamp[2 * layer + 1];
    const float inv = (c == 0) ? frcp(lrun) : lam * frcp(lrun);
    LAS float* cb = (LAS float*)(L + CB) + (32 * qs + r32) * 132;
    if (c == 1) {
#pragma unroll
        for (int dvb = 0; dvb < 4; ++dvb)
#pragma unroll
            for (int q4 = 0; q4 < 4; ++q4) *(LAS f32x4*)(cb + 32 * dvb + 8 * q4 + 4 * hh) = (f32x4){O[dvb][4 * q4] * inv, O[dvb][4 * q4 + 1] * inv, O[dvb][4 * q4 + 2] * inv, O[dvb][4 * q4 + 3] * inv};
    }
    LDS_WAIT(); __syncthreads();
    if (c == 0) {
        float ss = 0.f;
#pragma unroll
        for (int dvb = 0; dvb < 4; ++dvb)
#pragma unroll
            for (int q4 = 0; q4 < 4; ++q4) { const f32x4 o1 = *(const LAS f32x4*)(cb + 32 * dvb + 8 * q4 + 4 * hh);
#pragma unroll
                for (int e = 0; e < 4; ++e) { const float v = O[dvb][4 * q4 + e] * inv - o1[e]; O[dvb][4 * q4 + e] = v; ss += v * v; } }
        ss += __shfl_xor(ss, 32);
        const float rs = frsq(ss * (1.f / 128.f) + EPS) * (1.f - li);
        const float* gain = F.in[12] + layer * 128;
        bf16* mp = (bf16*)(F.ws + WS_MIX) + ((size_t)b * SEQ + tq) * D + MIX_A + h * 128;
        f32x4 gnv[16];
#pragma unroll
        for (int i = 0; i < 16; ++i) gnv[i] = *(const GAS f32x4*)(gain + 32 * (i >> 2) + 8 * (i & 3) + 4 * hh);
#pragma unroll
        for (int dvb = 0; dvb < 4; ++dvb)
#pragma unroll
            for (int q4 = 0; q4 < 4; ++q4) { const int dv = 32 * dvb + 8 * q4 + 4 * hh; const f32x4 gn = gnv[dvb * 4 + q4];
                v2u w; w.x = pk2(O[dvb][4 * q4] * rs * gn.x, O[dvb][4 * q4 + 1] * rs * gn.y); w.y = pk2(O[dvb][4 * q4 + 2] * rs * gn.z, O[dvb][4 * q4 + 3] * rs * gn.w);
                *(GAS v2u*)(mp + dv) = w; }
    }
    LDS_WAIT(); __syncthreads();
}
DI void attn_phase(const Frame& F, int qslot) {
    const int layer = qslot & 3;
    for (;;) {
        if (F.tid == 0) F.MISC[0] = __hip_atomic_fetch_add((unsigned*)(F.ctl + CW_QUEUE + 64 * qslot), 1u, RLX_AGENT);
        LDS_WAIT(); __syncthreads();
        const int u = (int)F.MISC[0];
        __syncthreads();
        if (u >= 256) break;
        attn_unit(F, u & 7, 31 - (u >> 3), layer);
    }
}
struct Args { const float* in[24]; float* out; unsigned char* ws; int ph_lo, ph_hi; };

#ifndef PROBE_DUP
#define PROBE_DUP 0
#endif
#ifndef PROBE_VAR
#define PROBE_VAR 0
#endif
#ifndef GEMM_SP2
#define GEMM_SP2 true
#endif
#ifndef RESID_ALIGN
#define RESID_ALIGN false
#endif
#define REPS(bit) (((PROBE_DUP >> (bit)) & 1) ? 2 : 1)
#define REP_SEAM(rep, bit) do { if ((rep) + 1 < REPS(bit)) xcd_barrier(bar); } while (0)
__global__ void __launch_bounds__(512, 2) mega_fwd(Args args) {
    extern __shared__ __attribute__((aligned(16))) unsigned char lds[];
    Frame F;
    F.lds = (LAS unsigned char*)lds;
    F.MISC = (volatile LAS unsigned*)(F.lds + MISC_OFF);
    F.tid = threadIdx.x; F.lane = F.tid & 63; F.wave = __builtin_amdgcn_readfirstlane(F.tid >> 6);
    F.G = gridDim.x; { const int bx = blockIdx.x; F.vcu = (F.G % 8 == 0) ? (bx % 8) * (F.G / 8) + bx / 8 : bx; }
    F.ws = args.ws; F.ctl = (gu32*)(args.ws + WS_CTL); F.out = args.out;
    F.in = (const CAS cfptr*)__builtin_amdgcn_kernarg_segment_ptr();
    if (F.tid < 64) F.MISC[F.tid] = 0u;
    __syncthreads();
    XcdBarrier bar; bar.bar = (unsigned*)(F.ctl + CW_BAR); bar.x = 0; bar.st = nullptr;
#if !MK_PER_PHASE
    bar = xcd_barrier_post((unsigned*)(F.ctl + CW_BAR), F.MISC + 8);
#endif
    const int lo = args.ph_lo, hi = args.ph_hi;
    int ph = 0;
#define IN_PH() (lo <= ph && ph < hi)
#if MK_PER_PHASE
#define SEAM() do { ++ph; } while (0)
#else
#define SEAM() do { if (lo <= ph && ph + 1 < hi) { xcd_barrier(bar); if ((PROBE_DUP >> 14) & 1) xcd_barrier(bar); } ++ph; } while (0)
#endif
#define PH(Fp) Frame Fp = F; { int t_; asm volatile("v_mbcnt_lo_u32_b32 %0, -1, 0\n\tv_mbcnt_hi_u32_b32 %0, -1, %0" : "=v"(t_)); t_ += F.wave * 64; asm volatile("" : "+v"(t_));     Fp.tid = t_; Fp.lane = t_ & 63; Fp.wave = __builtin_amdgcn_readfirstlane(t_ >> 6); \
        unsigned char* w_ = F.ws; asm volatile("" : "+s"(w_)); Fp.ws = w_; Fp.ctl = (gu32*)(w_ + WS_CTL); float* o_ = F.out; asm volatile("" : "+s"(o_)); Fp.out = o_; \
        const CAS cfptr* i_ = F.in; asm volatile("" : "+s"(i_)); Fp.in = i_; }
#ifndef SKIP_PRO
    if (IN_PH()) for (int rep = 0; rep < REPS(0); ++rep) { PH(Fp); p0_prologue(Fp, (rep + 1 < REPS(0)) ? PROBE_VAR : 0); REP_SEAM(rep, 0); }
#endif
    SEAM();
#pragma unroll 1
    for (int f = 0; f < NFFN; ++f) {
        const int l = f >> 1, s = f & 1;
        const int vin = 3 * l + (s ? 2 : 0);
        if (IN_PH()) for (int rep = 0; rep < REPS(1); ++rep) {
            PH(Fp);
            pg8::Gemm g{(const bf16*)(Fp.ws + WS_XB), (const bf16*)(Fp.ws + WS_WGU + (size_t)f * SZ_WGU1), M, NGU, D}; pg8::StaticOrder S; S.init(M, NGU, Fp.G, (int)blockIdx.x);
            pg8::EpiGateUp E{(bf16*)(Fp.ws + WS_ACT), rowsq_ptr(Fp, vin), DFF};
#ifndef SKIP_GEMM
            pg8::gemm_phase<pg8::EpiGateUp, pg8::StaticOrder, true, GEMM_SP2>(Fp.lds, g, S, E, Fp.tid);
#endif
            if (Fp.G == 256 && blockIdx.x >= 128 && rep == 0) {
                PH(Fc); int lo_, hi_; cv_slot(l, s ? 3 : 0, lo_, hi_);
                convert_range(Fc, lo_, hi_, ((int)blockIdx.x - 128) * 8 + Fc.wave, 128 * 8, (LAS float*)(Fc.lds + Fc.wave * 16896));
            }
            REP_SEAM(rep, 1);
        }
        SEAM();
        if (IN_PH()) for (int rep = 0; rep < REPS(2); ++rep) {
            PH(Fp);
            const bool dummy = rep + 1 < REPS(2);
            pg8::Gemm g{(const bf16*)(Fp.ws + WS_ACT), (const bf16*)(Fp.ws + WS_WD + (size_t)f * SZ_WD1), M, D, DFF}; pg8::StaticOrder S; S.init(M, D, Fp.G, (int)blockIdx.x);
            pg8::EpiResid E{(const bf16*)(Fp.ws + WS_XB), Fp.ws + WS_XLO, (bf16*)(Fp.ws + (dummy ? WS_MIX : WS_XB)), Fp.ws + (dummy ? WS_P : WS_XLO), rowsq_ptr(Fp, dummy ? 13 : vin + 1), dummy ? 0.f : 0.5f};
#ifndef SKIP_GEMM
            pg8::gemm_phase<pg8::EpiResid, pg8::StaticOrder, RESID_ALIGN, GEMM_SP2>(Fp.lds, g, S, E, Fp.tid);
#endif
            REP_SEAM(rep, 2);
        }
        SEAM();
        if (s == 0) {
            if (IN_PH()) for (int rep = 0; rep < REPS(3); ++rep) {
                PH(Fp);
                pg8::Gemm g{(const bf16*)(Fp.ws + WS_XB), (const bf16*)(Fp.ws + WS_WIN + (size_t)l * SZ_WIN1), M, DINP, D}; pg8::StaticOrder S; S.init(M, DINP, Fp.G, (int)blockIdx.x);
                pg8::EpiWin E{(bf16*)(Fp.ws + WS_P), (float*)(Fp.ws + WS_PBA), rowsq_ptr(Fp, 3 * l + 1), NP};
#ifndef SKIP_GEMM
                pg8::gemm_phase<pg8::EpiWin, pg8::StaticOrder, true, GEMM_SP2>(Fp.lds, g, S, E, Fp.tid);
#endif
                if (Fp.G == 256 && blockIdx.x >= 224 && rep == 0) {
                    PH(Fc); int lo_, hi_; cv_slot(l, 1, lo_, hi_);
                    convert_range(Fc, lo_, hi_, ((int)blockIdx.x - 224) * 8 + Fc.wave, 32 * 8, (LAS float*)(Fc.lds + Fc.wave * 16896));
                }
                REP_SEAM(rep, 3);
            }
            SEAM();
            if (IN_PH()) for (int rep = 0; rep < REPS(4); ++rep) {
#ifndef SKIP_GPREP
                for (int r3 = 0; r3 < REPS(11); ++r3) { PH(Fp); for (int j = Fp.vcu; j < 768; j += Fp.G) gdn_prep_job(Fp, j, l, (r3 + 1 < REPS(11)) ? PROBE_VAR : 0); }
#endif
#ifndef SKIP_HPREP
                for (int r3 = 0; r3 < REPS(12); ++r3) { PH(Fp); for (int j = Fp.vcu * 8 + Fp.wave; j < 1536; j += Fp.G * 8) hgrn_prep_job(Fp, j, l, Fp.lds + Fp.wave * 17408); }
#endif
                __syncthreads();
                for (int r3 = 0; r3 < REPS(13); ++r3) { PH(Fp); for (int j = Fp.vcu; j < 512; j += Fp.G) attn_prep_job(Fp, j); if (r3 == 0) gate_pass(Fp, l); }
                REP_SEAM(rep, 4);
            }
            SEAM();
            if (IN_PH()) for (int rep = 0; rep < REPS(5); ++rep) {
#ifndef SKIP_SCAN
                for (int r2 = 0; r2 < REPS(8); ++r2) {
                if (blockIdx.x < 12) { for (int r3 = 0; r3 < REPS(9); ++r3) { PH(Fp); gdn_scan(Fp, (int)blockIdx.x, l, (r3 + 1 < REPS(9)) ? PROBE_VAR : 0); } }
                else if (blockIdx.x < 24) { for (int r3 = 0; r3 < REPS(10); ++r3) { PH(Fp); hgrn_scan(Fp, (int)blockIdx.x - 12, l); } }
                }
#endif
#ifndef SKIP_ATTN
                for (int r2 = 0; r2 < REPS(7); ++r2) { PH(Fp); attn_phase(Fp, l + 4 * rep + 8 * r2); if (r2 + 1 < REPS(7)) xcd_barrier(bar); }
#endif
                if (F.G == 256 && blockIdx.x >= 24 && rep == 0) {
                    PH(Fc); int lo_, hi_; cv_slot(l, 2, lo_, hi_);
                    convert_range(Fc, lo_, hi_, ((int)blockIdx.x - 24) * 8 + Fc.wave, 232 * 8, (LAS float*)(Fc.lds + Fc.wave * 16896));
                }
                REP_SEAM(rep, 5);
            }
            SEAM();
            if (IN_PH()) for (int rep = 0; rep < REPS(6); ++rep) {
                PH(Fp);
                const bool dummy = rep + 1 < REPS(6);
                pg8::Gemm g{(const bf16*)(Fp.ws + WS_MIX), (const bf16*)(Fp.ws + WS_WOUT + (size_t)l * SZ_WOUT1), M, D, D}; pg8::StaticOrder S; S.init(M, D, Fp.G, (int)blockIdx.x);
                pg8::EpiResid E{(const bf16*)(Fp.ws + WS_XB), Fp.ws + WS_XLO, (bf16*)(Fp.ws + (dummy ? WS_ACT : WS_XB)), Fp.ws + (dummy ? WS_P : WS_XLO), rowsq_ptr(Fp, dummy ? 13 : 3 * l + 2), dummy ? 0.f : 1.0f};
    #ifndef SKIP_GEMM
            pg8::gemm_phase<pg8::EpiResid, pg8::StaticOrder, RESID_ALIGN, GEMM_SP2>(Fp.lds, g, S, E, Fp.tid);
#endif
            }
            SEAM();
        }
    }
    if (IN_PH()) {
        PH(Fp);
        const unsigned long long* rq = rowsq_ptr(Fp, 12); const float* w = Fp.in[23];
        const int gw = Fp.vcu * 8 + Fp.wave, NGW = Fp.G * 8;
        for (int m = gw; m < M; m += NGW) {
            const float rs = frsq((float)rq[m] * (1.f / (2048.f * 16777216.f)) + EPS);
            const GAS v2u* hr = (const GAS v2u*)((const bf16*)(Fp.ws + WS_XB) + (size_t)m * D) + Fp.lane; const unsigned char* lrow = Fp.ws + WS_XLO + (size_t)m * D;
            GAS f32x4* xr = (GAS f32x4*)(Fp.out + (size_t)m * D) + Fp.lane; const GAS f32x4* wr = (const GAS f32x4*)w + Fp.lane;
            v2u hv8[8]; unsigned lw8[8]; f32x4 ww8[8];
#pragma unroll
            for (int j = 0; j < 8; ++j) { hv8[j] = hr[64 * j]; ww8[j] = wr[64 * j];
                const int c = 256 * j + 4 * Fp.lane, cl = c & 255, bj = cl >> 7, wc = (cl & 127) >> 5, fq = (cl & 31) >> 3, k = cl & 7;
                lw8[j] = *(const GAS unsigned*)(lrow + (c & ~255) + ((wc * 4 + fq) * 2 + bj) * 8 + k); }
#pragma unroll
            for (int j = 0; j < 8; ++j) { const v2u hv = hv8[j]; const unsigned lw = lw8[j]; const f32x4 ww = ww8[j];
                f32x4 v = {pg8::e_x24(hv.x & 0xffffu, lw & 0xffu), pg8::e_x24(hv.x >> 16, (lw >> 8) & 0xffu), pg8::e_x24(hv.y & 0xffffu, (lw >> 16) & 0xffu), pg8::e_x24(hv.y >> 16, lw >> 24)};
                xr[64 * j] = v * rs * ww; }
        }
    }
#undef IN_PH
#undef SEAM
}

extern "C" void kernel_launch(void* const* d_in, const int* in_sizes, int n_in, void* d_out, int out_size, void* d_ws, size_t ws_size, hipStream_t stream) {
    static int grid = 0;
    if (grid == 0) {
        if (n_in != 24 || out_size != M * D || ws_size < WS_END) { fprintf(stderr, "kernel_launch: unexpected shapes: n_in %d out %d ws %zu (need %zu)\n", n_in, out_size, ws_size, (size_t)WS_END); grid = -1; return; }
        int dev = 0, cus = 0, per_cu = 0;
        if (hipGetDevice(&dev) != hipSuccess || hipDeviceGetAttribute(&cus, hipDeviceAttributeMultiprocessorCount, dev) != hipSuccess) { grid = -1; return; }
        if (hipFuncSetAttribute((const void*)mega_fwd, hipFuncAttributeMaxDynamicSharedMemorySize, LDS_BYTES) != hipSuccess) { fprintf(stderr, "kernel_launch: hipFuncSetAttribute failed\n"); grid = -1; return; }
        if (hipOccupancyMaxActiveBlocksPerMultiprocessor(&per_cu, (const void*)mega_fwd, 512, LDS_BYTES) != hipSuccess || per_cu < 1) { fprintf(stderr, "kernel_launch: occupancy query says %d\n", per_cu); }
        (void)hipGetLastError();
        grid = cus;
    }
    if (grid < 0) return;
    (void)hipMemsetAsync((char*)d_ws + WS_CTL, 0, CTL_ZERO_BYTES, stream);
    Args a{};
    for (int i = 0; i < 24; ++i) a.in[i] = (const float*)d_in[i];
    a.out = (float*)d_out; a.ws = (unsigned char*)d_ws;
    constexpr int NPH = 1 + NFFN * 2 + DEPTH * 4 + 1;
#if MK_PER_PHASE
    for (int p = 0; p < NPH; ++p) { a.ph_lo = p; a.ph_hi = p + 1; hipLaunchKernelGGL(mega_fwd, dim3(grid), dim3(512), LDS_BYTES, stream, a); }
#else
    a.ph_lo = 0; a.ph_hi = NPH;
    hipLaunchKernelGGL(mega_fwd, dim3(grid), dim3(512), LDS_BYTES, stream, a);
#endif
    const hipError_t le = hipPeekAtLastError();
    if (le != hipSuccess) fprintf(stderr, "kernel_launch: launch failed: %s\n", hipGetErrorName(le));
}
```
